# Optimizing an MI355X kernel written in HIP

```python
import math
import jax, jax.numpy as jnp
from jax import lax
import numpy as np

D_MODEL = 2048
BATCH = 4
SEQ = 4096
DEPTH = 1

HEAD_DIM = 128
A_Q_HEADS = 8
A_KV_HEADS = 2
A_GROUP = A_Q_HEADS // A_KV_HEADS
ROPE_THETA = 10000.0
GRID_W = 64
B_HEADS = 8
B_QK_DIM = 64
B_V_DIM = 2 * B_QK_DIM
REL_BUCKETS = 32
REL_MAX_DIST = 128
N_EXPERTS = 32
TOP_K = 4
D_FF = D_MODEL
SWIGLU_LIMIT = 7.0
SWIGLU_ALPHA = 1.702
MOE_BLOCK = 128
Q_BLOCK = 128
EPS = 1e-6

A_Q_W = A_Q_HEADS * HEAD_DIM
A_KV_W = A_KV_HEADS * HEAD_DIM
B_QK_W = B_HEADS * 2 * B_QK_DIM
B_V_W = B_HEADS * B_V_DIM
IN_W = A_Q_W + 2 * A_KV_W + 2 * B_QK_W + B_V_W
MIX_W = A_Q_W + B_V_W

kernel_name = "hymba_style_gqa_axialrope_diffattn_moe_encoder"


def lambda_init_for(layer_idx):
    return 0.8 - 0.6 * math.exp(-0.3 * layer_idx)


def rms_norm(x, g):
    xf = x.astype(jnp.float32)
    y = xf * lax.rsqrt(jnp.mean(xf * xf, axis=-1, keepdims=True) + EPS)
    return (y * g.astype(jnp.float32)).astype(x.dtype)


def axial_rope_tables(rows):
    row = jnp.repeat(jnp.arange(rows, dtype=jnp.float32), GRID_W)
    col = jnp.tile(jnp.arange(GRID_W, dtype=jnp.float32), rows)
    axis_dim = HEAD_DIM // 2
    inv = ROPE_THETA ** (-jnp.arange(0, axis_dim, 2, dtype=jnp.float32) / axis_dim)
    ang = jnp.concatenate([row[:, None] * inv, col[:, None] * inv], axis=-1)
    return jnp.cos(ang), jnp.sin(ang)


def apply_rope(x, cos, sin):
    xr = x.reshape(x.shape[:-1] + (HEAD_DIM // 2, 2)).astype(jnp.float32)
    c = cos[:, None, :]
    s = sin[:, None, :]
    x0, x1 = xr[..., 0], xr[..., 1]
    out = jnp.stack([x0 * c - x1 * s, x0 * s + x1 * c], axis=-1)
    return out.reshape(x.shape).astype(x.dtype)


def rel_bucket(rp):
    nb = REL_BUCKETS // 2
    max_exact = nb // 2
    ret = jnp.where(rp > 0, nb, 0)
    n = jnp.abs(rp)
    nf = jnp.maximum(n, 1).astype(jnp.float32)
    large = max_exact + (jnp.log(nf / max_exact) / math.log(REL_MAX_DIST / max_exact)
                         * (nb - max_exact)).astype(jnp.int32)
    large = jnp.minimum(large, nb - 1)
    return ret + jnp.where(n < max_exact, n, large)


def gqa_axial_attention(q, k, v):
    B, S = q.shape[:2]
    nb = S // Q_BLOCK
    qg = q.reshape(B, nb, Q_BLOCK, A_KV_HEADS, A_GROUP, HEAD_DIM).transpose(1, 0, 2, 3, 4, 5)
    scale = HEAD_DIM ** -0.5

    def block(qb):
        s = jnp.einsum('bqkgd,bskd->bkgqs', qb, k).astype(jnp.float32) * scale
        p = jax.nn.softmax(s, axis=-1).astype(v.dtype)
        return jnp.einsum('bkgqs,bskd->bqkgd', p, v)

    o = lax.map(block, qg)
    return o.transpose(1, 0, 2, 3, 4, 5).reshape(B, S, A_Q_W)


def diff_attention(q1, q2, k1, k2, v, rel_table, lam, subln_g, lambda_init):
    B, S = q1.shape[:2]
    nb = S // Q_BLOCK
    q1b = q1.reshape(B, nb, Q_BLOCK, B_HEADS, B_QK_DIM).transpose(1, 0, 2, 3, 4)
    q2b = q2.reshape(B, nb, Q_BLOCK, B_HEADS, B_QK_DIM).transpose(1, 0, 2, 3, 4)
    starts = jnp.arange(nb, dtype=jnp.int32) * Q_BLOCK
    k_pos = jnp.arange(S, dtype=jnp.int32)
    scale = B_QK_DIM ** -0.5

    def block(args):
        qa, qb, start = args
        q_pos = start + jnp.arange(Q_BLOCK, dtype=jnp.int32)
        bucket = rel_bucket(k_pos[None, :] - q_pos[:, None])
        bias = rel_table.astype(jnp.float32)[bucket].transpose(2, 0, 1)
        s1 = jnp.einsum('bqhd,bshd->bhqs', qa, k1).astype(jnp.float32) * scale + bias
        s2 = jnp.einsum('bqhd,bshd->bhqs', qb, k2).astype(jnp.float32) * scale + bias
        attn = jax.nn.softmax(s1, axis=-1) - lam * jax.nn.softmax(s2, axis=-1)
        o = jnp.einsum('bhqs,bshd->bqhd', attn.astype(v.dtype), v)
        return rms_norm(o, subln_g) * (1.0 - lambda_init)

    o = lax.map(block, (q1b, q2b, starts))
    return o.transpose(1, 0, 2, 3, 4).reshape(B, S, B_V_W)


def routed_experts(h, w_router, b_router, w_gu, b_gu, w_down, b_down):
    T, D = h.shape
    logits = (h @ w_router).astype(jnp.float32) + b_router.astype(jnp.float32)
    top_val, top_idx = lax.top_k(logits, TOP_K)
    gates = jax.nn.softmax(top_val, axis=-1)
    n_assign = T * TOP_K
    e_flat = top_idx.reshape(-1)
    tok_flat = jnp.arange(n_assign, dtype=jnp.int32) // TOP_K
    g_flat = gates.reshape(-1)
    order = jnp.argsort(e_flat)
    e_sorted = e_flat[order]
    tok_sorted = tok_flat[order]
    g_sorted = g_flat[order]
    counts = jnp.bincount(e_flat, length=N_EXPERTS)
    padded = (counts + MOE_BLOCK - 1) // MOE_BLOCK * MOE_BLOCK
    start = jnp.cumsum(counts) - counts
    pad_end = jnp.cumsum(padded)
    pad_start = pad_end - padded
    dest = pad_start[e_sorted] + (jnp.arange(n_assign, dtype=jnp.int32) - start[e_sorted])
    n_rows = n_assign + N_EXPERTS * MOE_BLOCK
    n_blocks = n_rows // MOE_BLOCK
    row_tok = jnp.full((n_rows,), T, jnp.int32).at[dest].set(tok_sorted)
    row_gate = jnp.zeros((n_rows,), jnp.float32).at[dest].set(g_sorted)
    block_expert = jnp.minimum(
        jnp.searchsorted(pad_end, jnp.arange(n_blocks, dtype=jnp.int32) * MOE_BLOCK, side='right'),
        N_EXPERTS - 1)
    h_pad = jnp.concatenate([h, jnp.zeros((1, D), h.dtype)], axis=0)

    def expert_block(args):
        toks, e = args
        xb = h_pad[toks]
        gu = xb @ w_gu[e] + b_gu[e]
        g, u = jnp.split(gu, 2, axis=-1)
        g = jnp.minimum(g, SWIGLU_LIMIT)
        u = jnp.clip(u, -SWIGLU_LIMIT, SWIGLU_LIMIT)
        glu = g * jax.nn.sigmoid(SWIGLU_ALPHA * g)
        return ((u + 1.0) * glu) @ w_down[e] + b_down[e]

    out = lax.map(expert_block, (row_tok.reshape(n_blocks, MOE_BLOCK), block_expert))
    out = out.reshape(n_rows, D) * row_gate[:, None].astype(out.dtype)
    y = jnp.zeros((T + 1, D), out.dtype).at[row_tok].add(out)
    return y[:T]


def setup_inputs(seed: int = 0) -> dict:
    key = jax.random.key(seed)
    ks = jax.random.split(key, 24)
    f32 = jnp.float32
    nrm = lambda k, shape, s: jax.random.normal(k, shape, f32) * s
    gain = lambda k, shape: 1.0 + 0.01 * jax.random.normal(k, shape, f32)
    return {
        "x": nrm(ks[0], (BATCH, SEQ, D_MODEL), 1.0),
        "c": nrm(ks[1], (BATCH, D_MODEL), 1.0),
        "rel_bias_table": nrm(ks[2], (REL_BUCKETS, B_HEADS), 0.5),
        "w_ada": nrm(ks[3], (DEPTH, D_MODEL, 6 * D_MODEL), 0.01),
        "b_ada": nrm(ks[4], (DEPTH, 6 * D_MODEL), 0.01),
        "norm_attn": gain(ks[5], (DEPTH, D_MODEL)),
        "norm_ffn": gain(ks[6], (DEPTH, D_MODEL)),
        "w_in": nrm(ks[7], (DEPTH, D_MODEL, IN_W), D_MODEL ** -0.5),
        "w_out": nrm(ks[8], (DEPTH, MIX_W, D_MODEL), MIX_W ** -0.5),
        "a_q_norm": gain(ks[9], (DEPTH, HEAD_DIM)),
        "a_k_norm": gain(ks[10], (DEPTH, HEAD_DIM)),
        "b_q_norm": gain(ks[11], (DEPTH, B_QK_DIM)),
        "b_k_norm": gain(ks[12], (DEPTH, B_QK_DIM)),
        "lambda_q1": nrm(ks[13], (DEPTH, B_QK_DIM), 0.1),
        "lambda_k1": nrm(ks[14], (DEPTH, B_QK_DIM), 0.1),
        "lambda_q2": nrm(ks[15], (DEPTH, B_QK_DIM), 0.1),
        "lambda_k2": nrm(ks[16], (DEPTH, B_QK_DIM), 0.1),
        "b_subln": gain(ks[17], (DEPTH, B_V_DIM)),
        "w_router": nrm(ks[18], (DEPTH, D_MODEL, N_EXPERTS), D_MODEL ** -0.5),
        "b_router": nrm(ks[19], (DEPTH, N_EXPERTS), 0.01),
        "w_gu": nrm(ks[20], (DEPTH, N_EXPERTS, D_MODEL, 2 * D_FF), D_MODEL ** -0.5),
        "b_gu": nrm(ks[21], (DEPTH, N_EXPERTS, 2 * D_FF), 0.01),
        "w_down": nrm(ks[22], (DEPTH, N_EXPERTS, D_FF, D_MODEL), D_FF ** -0.5),
        "b_down": nrm(ks[23], (DEPTH, N_EXPERTS, D_MODEL), 0.01),
    }


def reference(x, c, rel_bias_table, w_ada, b_ada, norm_attn, norm_ffn, w_in, w_out,
              a_q_norm, a_k_norm, b_q_norm, b_k_norm, lambda_q1, lambda_k1, lambda_q2,
              lambda_k2, b_subln, w_router, b_router, w_gu, b_gu, w_down, b_down):
    B, S, D = x.shape
    rows = S // GRID_W
    cos, sin = axial_rope_tables(rows)
    c_act = jax.nn.silu(c)
    for l in range(DEPTH):
        lam_init = lambda_init_for(l)
        mod = (c_act @ w_ada[l] + b_ada[l])[:, None, :]
        sh_a, sc_a, g_a, sh_f, sc_f, g_f = jnp.split(mod, 6, axis=-1)

        h = rms_norm(x, norm_attn[l]) * (1.0 + sc_a) + sh_a
        proj = h @ w_in[l]
        o0 = A_Q_W
        o1 = o0 + A_KV_W
        o2 = o1 + A_KV_W
        o3 = o2 + B_QK_W
        o4 = o3 + B_QK_W
        qa = proj[..., :o0].reshape(B, S, A_Q_HEADS, HEAD_DIM)
        ka = proj[..., o0:o1].reshape(B, S, A_KV_HEADS, HEAD_DIM)
        va = proj[..., o1:o2].reshape(B, S, A_KV_HEADS, HEAD_DIM)
        qa = apply_rope(rms_norm(qa, a_q_norm[l]), cos, sin)
        ka = apply_rope(rms_norm(ka, a_k_norm[l]), cos, sin)
        out_a = gqa_axial_attention(qa, ka, va)
        qb = rms_norm(proj[..., o2:o3].reshape(B, S, B_HEADS, 2, B_QK_DIM), b_q_norm[l])
        kb = rms_norm(proj[..., o3:o4].reshape(B, S, B_HEADS, 2, B_QK_DIM), b_k_norm[l])
        vb = proj[..., o4:].reshape(B, S, B_HEADS, B_V_DIM)
        lam = (jnp.exp(jnp.sum(lambda_q1[l].astype(jnp.float32) * lambda_k1[l].astype(jnp.float32)))
               - jnp.exp(jnp.sum(lambda_q2[l].astype(jnp.float32) * lambda_k2[l].astype(jnp.float32)))
               + lam_init)
        out_b = diff_attention(qb[..., 0, :], qb[..., 1, :], kb[..., 0, :], kb[..., 1, :], vb,
                               rel_bias_table, lam, b_subln[l], lam_init)
        mix = jnp.concatenate([out_a, out_b], axis=-1) @ w_out[l]
        x = x + g_a * mix

        h = rms_norm(x, norm_ffn[l]) * (1.0 + sc_f) + sh_f
        y = routed_experts(h.reshape(B * S, D), w_router[l], b_router[l], w_gu[l], b_gu[l],
                           w_down[l], b_down[l]).reshape(B, S, D)
        x = x + g_f * y
    return x
```

```cpp
#include <hip/hip_runtime.h>
#include <cstdio>
#include <cstdint>

#ifndef MK_ONE_LAUNCH
#define MK_ONE_LAUNCH 1
#endif

constexpr int NB = 4, SEQ = 4096, DM = 2048, T = NB * SEQ;
constexpr int INW = 4608, NE = 32, TOPK = 4, FF = 2048;
constexpr int COL_QA = 0, COL_KA = 1024, COL_VA = 1280, COL_QB = 1536, COL_KB = 2560, COL_VB = 3584;
constexpr int NASG = T * TOPK;
constexpr int MAXROWS = NASG + NE * 256;
constexpr float EPS = 1e-6f;
constexpr int NWAVES = 8, NTHR = 512;

constexpr size_t al256(size_t x) { return (x + 255) & ~(size_t)255; }
constexpr size_t WS_CTL = 0, CTL_BYTES = 1u << 20;
constexpr size_t WS_MOD  = WS_CTL + CTL_BYTES;
constexpr size_t WS_ROPE = WS_MOD + al256((size_t)NB * 6 * DM * 4);
constexpr size_t WS_BIAS = WS_ROPE + al256(2 * 64 * 32 * 4);
constexpr size_t WS_MISC = WS_BIAS + al256(8 * 512 * 4);
constexpr size_t WS_WIN  = WS_MISC + 256;
constexpr size_t WS_WOUT = WS_WIN + (size_t)INW * DM * 2;
constexpr size_t WS_WGU  = WS_WOUT + (size_t)DM * DM * 2;
constexpr size_t WS_WDN  = WS_WGU + (size_t)NE * 2 * FF * DM;
constexpr size_t WS_H    = WS_WDN + (size_t)NE * DM * FF;
constexpr size_t WS_PROJ = WS_H + (size_t)T * DM * 2;
constexpr size_t WS_AO   = WS_PROJ + (size_t)T * INW * 2;
constexpr size_t WS_STASH= WS_AO + (size_t)T * DM * 2;
constexpr size_t WS_ASGE = WS_STASH + (size_t)256 * 64 * 512 * 4;
constexpr size_t WS_ASGP = WS_ASGE + (size_t)NASG * 4;
constexpr size_t WS_ASGG = WS_ASGP + (size_t)NASG * 4;
constexpr size_t WS_ELIST = WS_ASGG + (size_t)NASG * 4;
constexpr size_t WS_EGATE = WS_ELIST + (size_t)NE * T * 4;
constexpr size_t WS_ACT  = WS_EGATE + (size_t)NE * T * 4;
constexpr size_t WS_Y    = WS_ACT + (size_t)MAXROWS * FF;
constexpr size_t WS_VT   = WS_Y + (size_t)MAXROWS * DM * 2;
constexpr size_t WS_KA8  = WS_VT + (size_t)NB * 10 * 64 * 8192;
constexpr size_t WS_KB8  = WS_KA8 + (size_t)NB * 2 * 64 * 8192;
constexpr size_t WS_WRP  = WS_KB8 + (size_t)NB * 16 * 64 * 4096;
constexpr size_t WS_RCST = WS_WRP + (size_t)NB * DM * NE * 4;
constexpr size_t WS_END  = WS_RCST + 512;
constexpr int CW_BAR = 4096;
constexpr int CW_ECNT = 8192;
constexpr size_t CTL_ZERO = 40960;
static_assert((CW_ECNT + NE * 16) * 4 <= (int)CTL_ZERO && (CW_BAR + 3456) * 4 <= (int)CTL_ZERO, "control words inside the per-call memset");

constexpr int RING_BYTES = 131072;
constexpr int XTR_OFF = RING_BYTES, XTR_BYTES = 20480;
constexpr int MISC_OFF = XTR_OFF + XTR_BYTES;
constexpr int EPI_OFF = MISC_OFF + 256, EPI_BYTES = 4096;
constexpr int LDS_BYTES = EPI_OFF + EPI_BYTES;
static_assert(LDS_BYTES <= 163840, "LDS");

#define GAS __attribute__((address_space(1)))
#define LAS __attribute__((address_space(3)))
typedef unsigned short bf16;
typedef unsigned u32x4 __attribute__((ext_vector_type(4)));
typedef unsigned u32x2 __attribute__((ext_vector_type(2)));
typedef float f32x4 __attribute__((ext_vector_type(4)));
typedef float f32x2 __attribute__((ext_vector_type(2)));
typedef float f32x16 __attribute__((ext_vector_type(16)));
typedef short bf16x8 __attribute__((ext_vector_type(8)));
typedef short s16x4 __attribute__((ext_vector_type(4)));
typedef GAS unsigned gu32;
#define RLX_AGENT __ATOMIC_RELAXED, __HIP_MEMORY_SCOPE_AGENT
#define LDS_WAIT() asm volatile("s_waitcnt lgkmcnt(0)" ::: "memory")
#define VM_WAIT() asm volatile("s_waitcnt vmcnt(0)" ::: "memory")
#define SBAR() __builtin_amdgcn_sched_barrier(0)

__device__ __forceinline__ unsigned cvtpk(float lo, float hi) { unsigned r; asm volatile("v_cvt_pk_bf16_f32 %0, %1, %2" : "=v"(r) : "v"(lo), "v"(hi)); return r; }
template <class T> __device__ __forceinline__ T* opaque_sptr(T* p) { asm volatile("" : "+s"(p)); return p; }
__device__ __forceinline__ int opaque_tid() { int t = threadIdx.x; asm volatile("" : "+v"(t)); return t; }
__device__ __forceinline__ float bf2f(unsigned short h) { return __builtin_bit_cast(float, (unsigned)h << 16); }
__device__ __forceinline__ float bflo(unsigned w) { return __builtin_bit_cast(float, w << 16); }
__device__ __forceinline__ float bfhi(unsigned w) { return __builtin_bit_cast(float, w & 0xffff0000u); }

#define XB_TMO      128
#define XB_XCNT(j)  (256  + 64 * (j))
#define XB_XSUB(j)  (1280 + 64 * (j))
#define XB_XGEN(j)  (2304 + 64 * (j))
#define XB_TOP      3328
#define XB_TOPGEN   3392
#define XCD_BAR_WORDS 3456
#define XB_SPIN_CAP (1u << 22)
__device__ __forceinline__ unsigned xb_ld(unsigned* p)              { return __hip_atomic_load(p, __ATOMIC_RELAXED, __HIP_MEMORY_SCOPE_AGENT); }
__device__ __forceinline__ unsigned xb_add(unsigned* p, unsigned v) { return __hip_atomic_fetch_add(p, v, __ATOMIC_RELAXED, __HIP_MEMORY_SCOPE_AGENT); }
__device__ __forceinline__ unsigned xb_xcc_id() { return (unsigned)__builtin_amdgcn_s_getreg((3 << 11) | 20) & 0xFu; }
#define XB_SPIN(cond, bar) do { unsigned _sp = 0; while (cond) { __builtin_amdgcn_s_sleep(1); \
    if ((++_sp & 255u) == 0u) { if (xb_ld(&(bar)[XB_TMO])) break; if (_sp > XB_SPIN_CAP) { atomicAdd(&(bar)[XB_TMO], 1u); break; } } } } while (0)
struct XcdBarrier { unsigned* bar; unsigned x; volatile LAS unsigned* st; };
__device__ __forceinline__ XcdBarrier xcd_barrier_post(unsigned* bar, volatile LAS unsigned* st) {
    XcdBarrier b; b.bar = bar; b.x = xb_xcc_id(); b.st = st;
    if (threadIdx.x == 0) (void)xb_add(&bar[XB_XCNT(b.x)], 1u);
    return b;
}
__device__ __forceinline__ void xcd_barrier_complete(unsigned* bar, unsigned x, unsigned& nloc, unsigned& nx) {
    const unsigned G = gridDim.x * gridDim.y * gridDim.z;
    unsigned sum, cnt, mine, sp = 0u;
    for (;;) {
        sum = 0u; cnt = 0u; mine = 0u;
#pragma unroll
        for (unsigned j = 0; j < 16; ++j) { const unsigned c = xb_ld(&bar[XB_XCNT(j)]); sum += c; cnt += (c > 0u) ? 1u : 0u; mine = (j == x) ? c : mine; }
        if (sum == G) break;
        __builtin_amdgcn_s_sleep(1);
        if ((++sp & 255u) == 0u) { if (xb_ld(&bar[XB_TMO])) break; if (sp > XB_SPIN_CAP) { atomicAdd(&bar[XB_TMO], 1u); break; } }
    }
    nloc = mine > 0u ? mine : 1u; nx = cnt > 0u ? cnt : 1u;
}
__device__ __forceinline__ void xcd_barrier(const XcdBarrier& b) {
    asm volatile("s_waitcnt vmcnt(0)" ::: "memory");
    __syncthreads();
    if (threadIdx.x == 0) {
        unsigned* bar = b.bar;
        __builtin_amdgcn_s_waitcnt(0);
        unsigned nloc = b.st[0], nx = b.st[1];
        if (nloc == 0u) { xcd_barrier_complete(bar, b.x, nloc, nx); b.st[0] = nloc; b.st[1] = nx; }
        const unsigned old = xb_add(&bar[XB_XSUB(b.x)], 1u);
        const unsigned gen = old / nloc;
        if (old + 1u == (gen + 1u) * nloc) {
            __builtin_amdgcn_fence(__ATOMIC_RELEASE, "agent");
            asm volatile("s_waitcnt vmcnt(0)" ::: "memory");
            const unsigned og = xb_add(&bar[XB_TOP], 1u);
            const unsigned tg = og / nx;
            if (og + 1u == (tg + 1u) * nx) xb_add(&bar[XB_TOPGEN], 1u);
            else XB_SPIN(xb_ld(&bar[XB_TOPGEN]) == tg, bar);
            __builtin_amdgcn_fence(__ATOMIC_ACQUIRE, "agent");
            xb_add(&bar[XB_XGEN(b.x)], 1u);
            asm volatile("s_waitcnt vmcnt(0)" ::: "memory");
        } else {
            XB_SPIN(xb_ld(&bar[XB_XGEN(b.x)]) == gen, bar);
            __builtin_amdgcn_fence(__ATOMIC_ACQUIRE, "agent");
            asm volatile("s_waitcnt vmcnt(0)" ::: "memory");
        }
    }
    __syncthreads();
}

namespace pg8 {
constexpr int BM = 256, BK = 64, HALF = 128, HTB = HALF * BK * 2, NXCD = 8, WGM = 8;
__host__ __device__ __forceinline__ int lds_byte(int r, int c) { const int st = (r >> 4) * 2 + (c >> 5), rr = r & 15, cc = c & 31, ob = rr * 64 + cc * 2; return st * 1024 + (ob ^ (((ob >> 9) & 1) << 5)); }
__host__ __device__ __forceinline__ void stage_rc(int b, int& R, int& C) { const int st = b / 1024, sb = b % 1024, swz = sb ^ (((sb >> 9) & 1) << 5); R = (st >> 1) * 16 + swz / 64; C = (st & 1) * 32 + (swz % 64) / 2; }
__host__ __device__ __forceinline__ int perm32(int rho) { const int n = rho >> 4, i = rho & 15; return 8 * (i >> 2) + 4 * n + (i & 3); }

struct Unit { int pm, pn, e, lr0, cnt; };
struct Gemm { const void* A; const void* Bt; int rowb; };

struct StaticOrder {
    int nM, nN, nwg, G, c, rowb;
    __device__ void init(int M, int N, int rowb_, int G_, int c_) { nM = M / BM; nN = N / BM; nwg = nM * nN; G = G_; c = c_; rowb = rowb_; }
    __device__ __forceinline__ bool next(int i, Unit& u) const {
        const long L = (long)i * G + c; if (L >= nwg) return false;
        int wgid = (int)L; { const int q = nwg / NXCD, r = nwg % NXCD, xcd = wgid % NXCD, off = wgid / NXCD; wgid = (xcd < r ? xcd * (q + 1) : r * (q + 1) + (xcd - r) * q) + off; }
        const int nig = WGM * nN, gid = wgid / nig, fm = gid * WGM, gsz = (nM - fm) < WGM ? (nM - fm) : WGM;
        u.pm = fm + ((wgid % nig) % gsz); u.pn = (wgid % nig) / gsz; u.e = 0; u.lr0 = 0; u.cnt = 0; return true;
    }
    __device__ __forceinline__ unsigned aoff(int, const Unit& u, int h, int R, int Cb) const { return (unsigned)((u.pm * BM + h * HALF + R) * rowb + Cb); }
};
template <bool GATHER> struct GroupedOrder {
    const LAS int* ul; int n; const LAS int* rt; int rowb;
    __device__ __forceinline__ bool next(int i, Unit& u) const {
        if (i >= n) return false;
        u.pm = __builtin_amdgcn_readfirstlane(ul[5 * i]); u.pn = __builtin_amdgcn_readfirstlane(ul[5 * i + 1]); u.e = __builtin_amdgcn_readfirstlane(ul[5 * i + 2]);
        u.lr0 = __builtin_amdgcn_readfirstlane(ul[5 * i + 3]); u.cnt = __builtin_amdgcn_readfirstlane(ul[5 * i + 4]); return true;
    }
    __device__ __forceinline__ unsigned aoff(int i, const Unit& u, int h, int R, int Cb) const {
        if (GATHER) return (unsigned)(rt[i * 256 + h * HALF + R] * rowb + Cb);
        return (unsigned)((u.pm * BM + h * HALF + R) * rowb + Cb);
    }
};

struct EpiProj {
    static constexpr bool PERM = true, PREF = false;
    bf16* O; int ldc; float sc;
    __device__ __forceinline__ void operator()(const f32x4 (&acc)[2][2][4][2], const Unit& u, int wr, int wc, int fr, int fq) const {
        const int row0 = u.pm * BM + wr * 64 + fr, col0 = u.pn * BM + wc * 32 + 8 * fq;
#pragma unroll
        for (int ai = 0; ai < 2; ++ai)
#pragma unroll
            for (int m = 0; m < 4; ++m) { bf16* rowp = O + (size_t)(row0 + ai * HALF + m * 16) * ldc + col0;
#pragma unroll
                for (int bj = 0; bj < 2; ++bj) { const f32x4 v0 = acc[ai][bj][m][0] * sc, v1 = acc[ai][bj][m][1] * sc;
                    u32x4 w; w.x = cvtpk(v0[0], v0[1]); w.y = cvtpk(v0[2], v0[3]); w.z = cvtpk(v1[0], v1[1]); w.w = cvtpk(v1[2], v1[3]);
                    *(u32x4*)(rowp + bj * HALF) = w; } }
    }
};
struct EpiResid {
    static constexpr bool PERM = false, PREF = false;
    const float* x; float* out; const float* ga; float sc;
    __device__ __forceinline__ void operator()(const f32x4 (&acc)[2][2][4][2], const Unit& u, int wr, int wc, int fr, int fq) const {
        const int row0 = u.pm * BM + wr * 64 + fr, col0 = u.pn * BM + wc * 32 + 4 * fq;
        const float* gab = ga + (size_t)((u.pm * BM) / SEQ) * 6 * DM;
        f32x4 gv[2][2];
#pragma unroll
        for (int bj = 0; bj < 2; ++bj)
#pragma unroll
            for (int n = 0; n < 2; ++n) gv[bj][n] = *(const f32x4*)(gab + col0 + bj * HALF + n * 16) * sc;
#pragma unroll
        for (int ai = 0; ai < 2; ++ai)
#pragma unroll
            for (int m = 0; m < 4; ++m) { const size_t ro = (size_t)(row0 + ai * HALF + m * 16) * DM + col0;
#pragma unroll
                for (int bj = 0; bj < 2; ++bj)
#pragma unroll
                    for (int n = 0; n < 2; ++n) { const f32x4 xv = *(const f32x4*)(x + ro + bj * HALF + n * 16);
                        *(f32x4*)(out + ro + bj * HALF + n * 16) = xv + gv[bj][n] * acc[ai][bj][m][n]; } }
    }
};
constexpr float WQ_SCALE = 32.f, ACT_SCALE = 4.f;
__device__ __forceinline__ unsigned pk4_fp8_x32(float a, float b, float c, float d) {
    unsigned r = 0; const float sc = 1.f / 32.f;
    asm("v_cvt_scalef32_pk_fp8_f32 %0, %1, %2, %3" : "+v"(r) : "v"(a), "v"(b), "v"(sc));
    asm("v_cvt_scalef32_pk_fp8_f32 %0, %1, %2, %3 op_sel:[0,0,0,1]" : "+v"(r) : "v"(c), "v"(d), "v"(sc));
    return r; }
__device__ __forceinline__ unsigned pk4_fp8_u(float a, float b, float c, float d) {
    unsigned old; asm volatile("" : "=v"(old)); unsigned p = __builtin_amdgcn_cvt_pk_fp8_f32(a, b, old, false); return __builtin_amdgcn_cvt_pk_fp8_f32(c, d, p, true); }
__device__ __forceinline__ unsigned pk4_fp8(float a, float b, float c, float d) {
    unsigned p = __builtin_amdgcn_cvt_pk_fp8_f32(a, b, 0, false); return __builtin_amdgcn_cvt_pk_fp8_f32(c, d, p, true); }
struct EpiSwiglu {
    static constexpr bool PERM = true, PREF = true;
    unsigned char* act; const float* bgu;
    __device__ __forceinline__ void prefetch(LAS unsigned char* ebuf, const Unit& u, int wid, int lane) const {
        if (wid == 0) { const int pnl = u.pn - u.e * 16; const float* src = bgu + (size_t)u.e * 2 * FF + pnl * 128 + (lane < 32 ? lane * 4 : FF + (lane - 32) * 4);
            __builtin_amdgcn_global_load_lds((const unsigned*)src, (LAS unsigned*)ebuf, 16, 0, 0); }
    }
    __device__ __forceinline__ void operator()(const f32x4 (&acc)[2][2][4][2], const Unit& u, int wr, int wc, int fr, int fq, const LAS unsigned char* ebuf) const {
        const int pnl = u.pn - u.e * 16, row0 = u.pm * BM + wr * 64 + fr, col0 = pnl * 128 + wc * 32 + 8 * fq;
        const LAS float* bl = (const LAS float*)ebuf + wc * 32 + 8 * fq;
        f32x4 bgv[2], buv[2];
#pragma unroll
        for (int n = 0; n < 2; ++n) { bgv[n] = *(const LAS f32x4*)(bl + 4 * n); buv[n] = *(const LAS f32x4*)(bl + 128 + 4 * n); }
#pragma unroll
        for (int ai = 0; ai < 2; ++ai)
#pragma unroll
            for (int m = 0; m < 4; ++m) { float o[8];
#pragma unroll
                for (int n = 0; n < 2; ++n)
#pragma unroll
                    for (int j = 0; j < 4; ++j) { float gg = acc[ai][0][m][n][j] * (1.f / WQ_SCALE) + bgv[n][j], uu = acc[ai][1][m][n][j] * (1.f / WQ_SCALE) + buv[n][j];
                        gg = fminf(gg, 7.f); uu = __builtin_amdgcn_fmed3f(uu, -7.f, 7.f);
                        const float glu = gg * __builtin_amdgcn_rcpf(1.f + __builtin_amdgcn_exp2f(gg * (-1.702f * 1.4426950408889634f)));
                        o[n * 4 + j] = fmaf(uu, ACT_SCALE, ACT_SCALE) * glu; }
                u32x2 w; w.x = pk4_fp8(o[0], o[1], o[2], o[3]); w.y = pk4_fp8(o[4], o[5], o[6], o[7]);
                *(u32x2*)(act + (size_t)(row0 + ai * HALF + m * 16) * FF + col0) = w; }
    }
};
constexpr float Y_SCALE = 16.f;
struct EpiDown {
    static constexpr bool PERM = true, PREF = true;
    unsigned char* y; const float* bdn; const float* egate;
    __device__ __forceinline__ void prefetch(LAS unsigned char* ebuf, const Unit& u, int wid, int lane) const {
        if (wid == 0) __builtin_amdgcn_global_load_lds((const unsigned*)(egate + (size_t)u.e * T + u.lr0 + lane * 4), (LAS unsigned*)ebuf, 16, 0, 0);
        if (wid == 1) { const int pnl = u.pn - u.e * 8; __builtin_amdgcn_global_load_lds((const unsigned*)(bdn + (size_t)u.e * DM + pnl * BM + lane * 4), (LAS unsigned*)(ebuf + 1024), 16, 0, 0); }
    }
    __device__ __forceinline__ void operator()(const f32x4 (&acc)[2][2][4][2], const Unit& u, int wr, int wc, int fr, int fq, const LAS unsigned char* ebuf) const {
        const int pnl = u.pn - u.e * 8, rl0 = wr * 64 + fr, row0 = u.pm * BM + rl0, col0 = pnl * BM + wc * 32 + 8 * fq;
        const LAS float* gl = (const LAS float*)ebuf; const LAS float* bl = (const LAS float*)(ebuf + 1024) + wc * 32 + 8 * fq;
        f32x4 bv[2][2];
#pragma unroll
        for (int bj = 0; bj < 2; ++bj)
#pragma unroll
            for (int n = 0; n < 2; ++n) bv[bj][n] = *(const LAS f32x4*)(bl + bj * HALF + 4 * n);
#pragma unroll
        for (int ai = 0; ai < 2; ++ai)
#pragma unroll
            for (int m = 0; m < 4; ++m) { const int rl = rl0 + ai * HALF + m * 16, row = u.pm * BM + rl; const float gt = (u.lr0 + rl) < u.cnt ? gl[rl] * Y_SCALE : 0.f; unsigned char* rowp = y + (size_t)row * DM + col0;
#pragma unroll
                for (int bj = 0; bj < 2; ++bj) { const f32x4 v0 = (acc[ai][bj][m][0] * (1.f / (WQ_SCALE * ACT_SCALE)) + bv[bj][0]) * gt, v1 = (acc[ai][bj][m][1] * (1.f / (WQ_SCALE * ACT_SCALE)) + bv[bj][1]) * gt;
                    u32x2 w; w.x = pk4_fp8(v0[0], v0[1], v0[2], v0[3]); w.y = pk4_fp8(v1[0], v1[1], v1[2], v1[3]);
                    *(u32x2*)(rowp + bj * HALF) = w; } }
    }
};

typedef int v8i __attribute__((ext_vector_type(8)));
template <class Epi, class Sched, bool ALIGN_EPI, bool F8>
__device__ __forceinline__ void gemm_phase(LAS unsigned char* lds, const Gemm g, const Sched& S, const Epi& E) {
    const int tid = opaque_tid(), wid = __builtin_amdgcn_readfirstlane(tid >> 6), lane = tid & 63, wr = wid >> 2, wc = wid & 3, fr = lane & 15, fq = lane >> 4;
    const int rowb = g.rowb, nt = rowb / 128;
    int Rs[2], Cs[2]; unsigned voffB[2];
#pragma unroll
    for (int i = 0; i < 2; ++i) { int R, C; stage_rc(tid * 16 + i * 8192, R, C); Rs[i] = R; Cs[i] = C * 2; const int Rb = Epi::PERM ? ((R & ~31) + perm32(R & 31)) : R; voffB[i] = (unsigned)(Rb * rowb + C * 2); }
    const size_t kstep = (size_t)128;
    const size_t hstep = (size_t)HALF * rowb;
    const size_t tstep = 2 * hstep;
    const unsigned ldsw = (unsigned)wid * 1024u;
    const int aoffl = lds_byte(wr * 64 + fr, fq * 8), boffl = lds_byte(wc * 32 + fr, fq * 8);
#define PG8_SA(b, h) (((b) * 2 + (h)) * HTB)
#define PG8_SB(b, h) ((4 + (b) * 2 + (h)) * HTB)
#define PG8_STAGE(bufoff, gbase, voff) do { _Pragma("unroll") for (int _i = 0; _i < 2; ++_i) \
        __builtin_amdgcn_global_load_lds((const unsigned*)((const char*)(gbase) + (voff)[_i]), (LAS unsigned*)(lds + (bufoff) + ldsw + _i * 8192), 16, 0, 0); } while (0)
#define PG8_LDA(dst, b, h) do { _Pragma("unroll") for (int m = 0; m < 4; ++m) _Pragma("unroll") for (int k = 0; k < 2; ++k) dst[m][k] = *(const LAS bf16x8*)(lds + PG8_SA(b, h) + aoffl + m * 2048 + k * 1024); } while (0)
#define PG8_LDB(dst, b, h) do { _Pragma("unroll") for (int n = 0; n < 2; ++n) _Pragma("unroll") for (int k = 0; k < 2; ++k) dst[n][k] = *(const LAS bf16x8*)(lds + PG8_SB(b, h) + boffl + n * 2048 + k * 1024); } while (0)
#define PG8_CAT(x) __builtin_bit_cast(v8i, __builtin_shufflevector(x[0], x[1], 0, 1, 2, 3, 4, 5, 6, 7, 8, 9, 10, 11, 12, 13, 14, 15))
#define PG8_MMA(ai, bj, At, Bt) do { __builtin_amdgcn_s_setprio(1); _Pragma("unroll") for (int m = 0; m < 4; ++m) _Pragma("unroll") for (int n = 0; n < 2; ++n) { \
        if constexpr (F8) { const v8i _b = PG8_CAT(Bt[n]), _a = PG8_CAT(At[m]); asm volatile("s_nop 1\n\tv_mfma_f32_16x16x128_f8f6f4 %0, %1, %2, %0" : "+v"(acc[ai][bj][m][n]) : "v"(_b), "v"(_a)); } \
        else { _Pragma("unroll") for (int k = 0; k < 2; ++k) acc[ai][bj][m][n] = __builtin_amdgcn_mfma_f32_16x16x32_bf16(Bt[n][k], At[m][k], acc[ai][bj][m][n], 0, 0, 0); } } \
        __builtin_amdgcn_s_setprio(0); } while (0)
#define PG8_WAIT_V(n) asm volatile("s_waitcnt vmcnt(" #n ")" ::: "memory")
#define PG8_WAIT_L(n) asm volatile("s_waitcnt lgkmcnt(" #n ")" ::: "memory")
#define PG8_BAR __builtin_amdgcn_s_barrier()
#define PG8_SCHED __builtin_amdgcn_sched_barrier(0)
    Unit cur, nxt; int ui = 0;
    if (!S.next(0, cur)) return;
    f32x4 acc[2][2][4][2];
#pragma unroll
    for (int a = 0; a < 2; ++a)
#pragma unroll
        for (int b = 0; b < 2; ++b)
#pragma unroll
            for (int m = 0; m < 4; ++m)
#pragma unroll
                for (int n = 0; n < 2; ++n) acc[a][b][m][n] = (f32x4){0.f, 0.f, 0.f, 0.f};
    bf16x8 At[4][2], B0[2][2], B1[2][2];
    unsigned aoc[2][2], aon[2][2];
#pragma unroll
    for (int h = 0; h < 2; ++h)
#pragma unroll
        for (int i = 0; i < 2; ++i) aoc[h][i] = S.aoff(0, cur, h, Rs[i], Cs[i]);
    const char* Ab = (const char*)g.A;
    const char* cB = (const char*)g.Bt + (size_t)cur.pn * tstep;
    PG8_STAGE(PG8_SB(0, 0), cB, voffB); PG8_STAGE(PG8_SB(0, 1), cB + hstep, voffB); PG8_STAGE(PG8_SA(0, 0), Ab, aoc[0]); PG8_STAGE(PG8_SA(0, 1), Ab, aoc[1]);
    if (wr == 1) PG8_BAR;
    PG8_WAIT_V(2); PG8_BAR;
    PG8_STAGE(PG8_SB(1, 0), cB + kstep, voffB); PG8_STAGE(PG8_SA(1, 0), Ab + kstep, aoc[0]); PG8_STAGE(PG8_SB(1, 1), cB + hstep + kstep, voffB);
    PG8_WAIT_V(6); PG8_BAR;
    for (;;) {
        if constexpr (Epi::PREF) E.prefetch(lds + EPI_OFF + (ui & 1) * 2048, cur, wid, lane);
        const bool has_next = S.next(ui + 1, nxt);
#pragma unroll
        for (int h = 0; h < 2; ++h)
#pragma unroll
            for (int i = 0; i < 2; ++i) aon[h][i] = has_next ? S.aoff(ui + 1, nxt, h, Rs[i], Cs[i]) : aoc[h][i];
        const char* nB = has_next ? (const char*)g.Bt + (size_t)nxt.pn * tstep : cB;
        for (int t = 0; t < nt; t += 2) {
            const bool last = (t == nt - 2);
            const char* a1 = Ab + (size_t)(t + 1) * kstep;
            const char* a2 = last ? Ab : Ab + (size_t)(t + 2) * kstep; const char* b2 = last ? nB : cB + (size_t)(t + 2) * kstep;
            const char* a3 = a2 + kstep; const char* b3 = b2 + kstep;
            unsigned a2o[2][2];
#pragma unroll
            for (int h = 0; h < 2; ++h)
#pragma unroll
                for (int i = 0; i < 2; ++i) a2o[h][i] = last ? aon[h][i] : aoc[h][i];
            PG8_LDB(B0, 0, 0); PG8_LDB(B1, 0, 1); PG8_SCHED; PG8_LDA(At, 0, 0); PG8_STAGE(PG8_SA(1, 1), a1, aoc[1]);
            PG8_WAIT_V(8); PG8_WAIT_L(0); PG8_BAR; PG8_MMA(0, 0, At, B0); PG8_MMA(0, 1, At, B1); PG8_BAR; PG8_SCHED;
            PG8_LDA(At, 0, 1); PG8_STAGE(PG8_SB(0, 0), b2, voffB); PG8_STAGE(PG8_SB(0, 1), b2 + hstep, voffB); PG8_STAGE(PG8_SA(0, 0), a2, a2o[0]);
            PG8_WAIT_V(8); PG8_WAIT_L(0); PG8_BAR; PG8_MMA(1, 0, At, B0); PG8_MMA(1, 1, At, B1); PG8_BAR; PG8_SCHED;
            PG8_LDB(B0, 1, 0); PG8_LDB(B1, 1, 1); PG8_SCHED; PG8_LDA(At, 1, 0); PG8_STAGE(PG8_SA(0, 1), a2, a2o[1]);
            PG8_WAIT_V(8); PG8_WAIT_L(0); PG8_BAR; PG8_MMA(0, 0, At, B0); PG8_MMA(0, 1, At, B1); PG8_BAR; PG8_SCHED;
            PG8_LDA(At, 1, 1); PG8_STAGE(PG8_SB(1, 0), b3, voffB); PG8_STAGE(PG8_SB(1, 1), b3 + hstep, voffB); PG8_STAGE(PG8_SA(1, 0), a3, a2o[0]);
            PG8_WAIT_V(8); PG8_WAIT_L(0); PG8_BAR; PG8_MMA(1, 0, At, B0); PG8_MMA(1, 1, At, B1); PG8_BAR; PG8_SCHED;
        }
        if constexpr (ALIGN_EPI) { if (wr == 0) PG8_BAR; }
        if constexpr (F8) asm volatile("s_nop 7\n\ts_nop 7\n\ts_nop 7" ::: "memory");
        if constexpr (Epi::PREF) E(acc, cur, wr, wc, fr, fq, lds + EPI_OFF + (ui & 1) * 2048); else E(acc, cur, wr, wc, fr, fq);
        if (!has_next) break;
#pragma unroll
        for (int a = 0; a < 2; ++a)
#pragma unroll
            for (int b = 0; b < 2; ++b)
#pragma unroll
                for (int m = 0; m < 4; ++m)
#pragma unroll
                    for (int n = 0; n < 2; ++n) acc[a][b][m][n] = (f32x4){0.f, 0.f, 0.f, 0.f};
        cur = nxt; cB = nB; ++ui;
#pragma unroll
        for (int h = 0; h < 2; ++h)
#pragma unroll
            for (int i = 0; i < 2; ++i) aoc[h][i] = aon[h][i];
        if constexpr (ALIGN_EPI) { if (wr == 1) PG8_BAR; }
    }
    PG8_WAIT_V(0);
    if constexpr (!ALIGN_EPI) { if (wr == 0) PG8_BAR; }
    PG8_BAR;
#undef PG8_SA
#undef PG8_SB
#undef PG8_STAGE
#undef PG8_LDA
#undef PG8_LDB
#undef PG8_MMA
#undef PG8_CAT
#undef PG8_WAIT_V
#undef PG8_WAIT_L
#undef PG8_BAR
#undef PG8_SCHED
}
}

struct Frame {
    LAS unsigned char* lds;
    volatile LAS unsigned* MISC;
    gu32* ctl;
    unsigned char* ws;
    int tid, lane, wave, vcu, G;
    const float *x, *c, *relb, *w_ada, *b_ada, *norm_attn, *norm_ffn, *w_in, *w_out, *a_q_norm, *a_k_norm, *b_q_norm, *b_k_norm,
                *lq1, *lk1, *lq2, *lk2, *b_subln, *w_router, *b_router, *w_gu, *b_gu, *w_down, *b_down;
    float* out;
};
__device__ __forceinline__ float wave_sum(float v) {
#pragma unroll
    for (int o = 1; o < 64; o <<= 1) v += __shfl_xor(v, o);
    return v;
}
__device__ __forceinline__ unsigned f2bf(float f) { unsigned u = __builtin_bit_cast(unsigned, f); return (u + 0x7fffu + ((u >> 16) & 1u)) >> 16; }
__device__ __forceinline__ unsigned pk2(float lo, float hi) { return f2bf(lo) | (f2bf(hi) << 16); }

constexpr int P0_ITEMS_A = (DM / 64) * (INW / 32) + (DM / 64) * (DM / 32);
constexpr int P0_ITEMS_ALL = P0_ITEMS_A + NE * ((DM / 64) * (2 * FF / 32) + (FF / 64) * (DM / 32));
struct WItem { const float* src; unsigned char* dst; int N, pitch, f8; };
__device__ __forceinline__ void witem_decode(Frame& F, int it, WItem& d) {
    constexpr int I_IN = (DM / 64) * (INW / 32), I_OUT = (DM / 64) * (DM / 32), I_GU1 = (DM / 64) * (2 * FF / 32), I_DN1 = (FF / 64) * (DM / 32);
    constexpr int I_GU = NE * I_GU1;
    int r = it;
    if (r < I_IN) { const int nblk = INW / 32, kb = r / nblk, nb = r % nblk; d.src = F.w_in + (size_t)(64 * kb) * INW + 32 * nb; d.N = INW; d.pitch = DM; d.f8 = 1;
        d.dst = F.ws + WS_WIN + (size_t)(32 * nb) * DM + 64 * kb; return; } r -= I_IN;
    if (r < I_OUT) { const int nblk = DM / 32, kb = r / nblk, nb = r % nblk; d.src = F.w_out + (size_t)(64 * kb) * DM + 32 * nb; d.N = DM; d.pitch = DM; d.f8 = 1;
        d.dst = F.ws + WS_WOUT + (size_t)(32 * nb) * DM + 64 * kb; return; } r -= I_OUT;
    if (r < I_GU) { const int e = r / I_GU1, q = r % I_GU1, nblk = 2 * FF / 32, kb = q / nblk, nb = q % nblk, n0 = 32 * nb;
        const int half = n0 / FF, nn = n0 % FF, orow = (nn / 128) * 256 + half * 128 + (nn % 128);
        d.src = F.w_gu + (size_t)e * DM * 2 * FF + (size_t)(64 * kb) * (2 * FF) + n0; d.N = 2 * FF; d.pitch = DM; d.f8 = 1;
        d.dst = F.ws + WS_WGU + (size_t)e * 2 * FF * DM + (size_t)orow * DM + 64 * kb; return; } r -= I_GU;
    { const int e = r / I_DN1, q = r % I_DN1, nblk = DM / 32, kb = q / nblk, nb = q % nblk;
        d.src = F.w_down + (size_t)e * FF * DM + (size_t)(64 * kb) * DM + 32 * nb; d.N = DM; d.pitch = FF; d.f8 = 1;
        d.dst = F.ws + WS_WDN + (size_t)e * DM * FF + (size_t)(32 * nb) * FF + 64 * kb; }
}

#define WC_PARAMS int& wc_it, int& wc_cur, int& wc_q
#define WC_ARGS wc_it, wc_cur, wc_q
constexpr int WC_END = P0_ITEMS_ALL;
__device__ __forceinline__ void moe_item(Frame& F, int it, const float*& src, int& N, unsigned char*& dst) {
    constexpr int I_GU = NE * (DM / 64) * (2 * FF / 32);
    const unsigned r = (unsigned)(it - P0_ITEMS_A);
    if (r < (unsigned)I_GU) { const unsigned e = r >> 12, q = r & 4095u, kb = q >> 7, n0 = (q & 127u) << 5, half = n0 >> 11, nn = n0 & 2047u, orow = ((nn >> 7) << 8) + (half << 7) + (nn & 127u);
        src = F.w_gu + ((size_t)e << 23) + ((size_t)kb << 18) + n0; N = 2 * FF; dst = F.ws + WS_WGU + ((size_t)e << 23) + ((size_t)orow << 11) + (kb << 6); }
    else { const unsigned r2 = r - I_GU, e = r2 >> 11, q = r2 & 2047u, kb = q >> 6, n0 = (q & 63u) << 5;
        src = F.w_down + ((size_t)e << 22) + ((size_t)kb << 17) + n0; N = DM; dst = F.ws + WS_WDN + ((size_t)e << 22) + ((size_t)n0 << 11) + (kb << 6); }
}
__device__ __forceinline__ void glds16_nt(const void* sbase, unsigned voff, unsigned lds_dst) { unsigned keep;
    asm volatile("s_mov_b32 %0, m0\n\ts_mov_b32 m0, %2\n\ts_nop 0\n\tglobal_load_lds_dwordx4 %1, %3 nt\n\ts_mov_b32 m0, %0" : "=&s"(keep) : "v"(voff), "s"(lds_dst), "s"(sbase) : "memory"); }
__device__ __forceinline__ void glds16(const void* sbase, unsigned voff, unsigned lds_dst) { unsigned keep;
    asm volatile("s_mov_b32 %0, m0\n\ts_mov_b32 m0, %2\n\ts_nop 0\n\tglobal_load_lds_dwordx4 %1, %3\n\ts_mov_b32 m0, %0" : "=&s"(keep) : "v"(voff), "s"(lds_dst), "s"(sbase) : "memory"); }
__device__ __forceinline__ void wconv_issue(Frame& F, WC_PARAMS, LAS char* buf, int lane, const int half = 2) {
    const int it = (half == 1) ? wc_cur : wc_it;
    if (it >= 0 && it < WC_END) { const float* src; int N; unsigned char* dst; moe_item(F, it, src, N, dst);
        const unsigned r = lane >> 3, cc = lane & 7; const unsigned lb = (unsigned)__builtin_amdgcn_readfirstlane((int)(unsigned)(unsigned long)buf);
        const unsigned vrow = r * (unsigned)N * 4u;
#pragma unroll
        for (int i = 0; i < 8; ++i) if (half == 2 || (i >> 2) == half) glds16_nt(src + (size_t)(8 * i) * N, vrow + ((cc ^ (unsigned)i) << 4), lb + i * 1024);
        if (half != 1) { wc_cur = wc_it; wc_it += F.G * NWAVES; }
    } else if (half != 1) wc_cur = -1;
}
__device__ __forceinline__ void wconv_step(Frame& F, WC_PARAMS, LAS char* buf, int lane, bool last) {
    if (wc_q & 16) { wc_q &= 15; wconv_issue(F, WC_ARGS, buf, lane, 1); }
    if (++wc_q == 4) { wc_q = 0;
        if (wc_cur >= 0) { const float* src; int N; unsigned char* dst; moe_item(F, wc_cur, src, N, dst);
            const int c8 = lane & 7;
            typedef float f32x2_ __attribute__((ext_vector_type(2)));
            static_assert(pg8::WQ_SCALE == 32.f, "scale folded into the conversion");
#define WC_ADDR(qd_) ((unsigned)(unsigned long)buf + 4u * (unsigned)((8 * c8) * 32 + 4 * (((8 * (qd_) + (lane >> 3)) >> 2) ^ c8) + ((8 * (qd_) + (lane >> 3)) & 3)))
#define WC_READ(R0, R1, R2, R3, qd_) asm volatile("ds_read2_b32 %0, %4 offset1:32\n\tds_read2_b32 %1, %4 offset0:64 offset1:96\n\tds_read2_b32 %2, %4 offset0:128 offset1:160\n\tds_read2_b32 %3, %4 offset0:192 offset1:224" \
                : "=&v"(R0), "=&v"(R1), "=&v"(R2), "=&v"(R3) : "v"(WC_ADDR(qd_)) : "memory")
#define WC_WAIT(n_, R0, R1, R2, R3) asm volatile("s_waitcnt lgkmcnt(" #n_ ")" : "+v"(R0), "+v"(R1), "+v"(R2), "+v"(R3) :: "memory")
#define WC_PUT(R0, R1, R2, R3, qd_) do { u32x2 o_; o_.x = pg8::pk4_fp8_x32(R0.x, R0.y, R1.x, R1.y); o_.y = pg8::pk4_fp8_x32(R2.x, R2.y, R3.x, R3.y); \
                __builtin_nontemporal_store(o_, (GAS u32x2*)(dst + ((size_t)(8 * (qd_) + (lane >> 3)) << 11) + 8 * c8)); } while (0)
            { f32x2_ a0, a1, a2, a3, b0, b1, b2, b3;
              asm volatile("s_waitcnt lgkmcnt(0)" ::: "memory");
              WC_READ(a0, a1, a2, a3, 0); WC_READ(b0, b1, b2, b3, 1);
              WC_WAIT(4, a0, a1, a2, a3); WC_PUT(a0, a1, a2, a3, 0); WC_READ(a0, a1, a2, a3, 2);
              WC_WAIT(4, b0, b1, b2, b3); WC_PUT(b0, b1, b2, b3, 1); WC_READ(b0, b1, b2, b3, 3);
              WC_WAIT(4, a0, a1, a2, a3); WC_PUT(a0, a1, a2, a3, 2);
              WC_WAIT(0, b0, b1, b2, b3); WC_PUT(b0, b1, b2, b3, 3); }
#undef WC_ADDR
#undef WC_READ
#undef WC_WAIT
#undef WC_PUT
            wc_cur = -1; }
        if (!last) { LDS_WAIT(); wconv_issue(F, WC_ARGS, buf, lane, 0); if (wc_cur >= 0) wc_q |= 16; }
    }
}

namespace attn {
constexpr int KVBLK = 64, QBLK = 32;
constexpr float THR = 2.f;
constexpr float PSH = 4.f;
constexpr int LDR = INW;
constexpr int SHM_V = 128 * KVBLK, SHM_K = KVBLK * 128 * 2;
constexpr int OFF_V = 0, OFF_K = 3 * 8192, OFF_WS = OFF_K + 3 * 8192, OFF_BT = OFF_WS + NWAVES * 64 * 4, OFF_OST = OFF_BT + 512 * 4, ATTN_LDS = OFF_OST + NWAVES * 8192;
static_assert(ATTN_LDS <= MISC_OFF, "attention LDS");
#define KSWZ128(row, colB) ((row) * 256 + ((colB) ^ (((row) & 7) << 4)))
#define KSWZ64(row, colB)  ((row) * 128 + ((colB) ^ ((((row) >> 1) & 7) << 4)))
__device__ __forceinline__ int crow(int r, int hi) { return (r & 3) + 8 * (r >> 2) + 4 * hi; }

__device__ __forceinline__ void partialSM(f32x16& p0, f32x16& p1, float& m_reg, float& mn, float& alpha, const float C, const float thr_raw, const float braw) {
  float pmax = p0[0];
#pragma unroll
  for (int r = 1; r < 16; ++r) pmax = fmaxf(pmax, p0[r]);
#pragma unroll
  for (int r = 0; r < 16; ++r) pmax = fmaxf(pmax, p1[r]);
  { auto rr = __builtin_amdgcn_permlane32_swap(__float_as_uint(pmax), __float_as_uint(pmax), false, false);
    pmax = fmaxf(__uint_as_float(rr[0]), __uint_as_float(rr[1])); }
  pmax += braw;
  if (__builtin_expect(__all(pmax - m_reg <= thr_raw), 1)) { mn = m_reg; alpha = 1.f; }
  else { mn = fmaxf(m_reg, pmax); alpha = __builtin_amdgcn_exp2f((m_reg - mn) * C); m_reg = mn; }
  const float mnC = (braw - mn) * C + PSH;
#pragma unroll
  for (int r = 0; r < 16; ++r) p0[r] = fmaf(p0[r], C, mnC);
#pragma unroll
  for (int r = 0; r < 16; ++r) p1[r] = fmaf(p1[r], C, mnC);
#pragma unroll
  for (int r = 0; r < 16; ++r) p0[r] = __builtin_amdgcn_exp2f(p0[r]);
}
__device__ __forceinline__ void finishSM(f32x16& p0, f32x16& p1, pg8::v8i& pa) {
#pragma unroll
  for (int r = 0; r < 16; ++r) p1[r] = __builtin_amdgcn_exp2f(p1[r]);
  pa[0] = (int)pg8::pk4_fp8_u(p0[0], p0[1], p0[2], p0[3]);   pa[1] = (int)pg8::pk4_fp8_u(p0[4], p0[5], p0[6], p0[7]);
  pa[2] = (int)pg8::pk4_fp8_u(p0[8], p0[9], p0[10], p0[11]); pa[3] = (int)pg8::pk4_fp8_u(p0[12], p0[13], p0[14], p0[15]);
  pa[4] = (int)pg8::pk4_fp8_u(p1[0], p1[1], p1[2], p1[3]);   pa[5] = (int)pg8::pk4_fp8_u(p1[4], p1[5], p1[6], p1[7]);
  pa[6] = (int)pg8::pk4_fp8_u(p1[8], p1[9], p1[10], p1[11]); pa[7] = (int)pg8::pk4_fp8_u(p1[12], p1[13], p1[14], p1[15]);
}
template <int ND0> __device__ __forceinline__ void qkt(f32x16& p0, f32x16& p1, const LAS char* Ks, const bf16x8 (&qr)[ND0], int r32, int hi) {
  p0 = f32x16{}; p1 = f32x16{};
#pragma unroll
  for (int d0 = 0; d0 < ND0; ++d0) { const int cb = (d0 * 16 + hi * 8) * 2;
    bf16x8 b0, b1;
    if (ND0 == 8) { b0 = *(const LAS bf16x8*)(Ks + KSWZ128(r32, cb)); b1 = *(const LAS bf16x8*)(Ks + KSWZ128(32 + r32, cb)); }
    else          { b0 = *(const LAS bf16x8*)(Ks + KSWZ64(r32, cb));  b1 = *(const LAS bf16x8*)(Ks + KSWZ64(32 + r32, cb)); }
    p0 = __builtin_amdgcn_mfma_f32_32x32x16_bf16(b0, qr[d0], p0, 0, 0, 0);
    p1 = __builtin_amdgcn_mfma_f32_32x32x16_bf16(b1, qr[d0], p1, 0, 0, 0); }
}
struct QF8 { pg8::v8i f[2]; };
__device__ __forceinline__ void qkt8(f32x16& p0, f32x16& p1, const LAS char* Ks, const QF8& q, int r32, int hi) {
  const int sw = (r32 >> 1) & 7, rb = r32 * 128;
  const int o00 = rb + (((2 * hi) ^ sw) << 4), o01 = rb + (((2 * hi + 1) ^ sw) << 4), o10 = rb + (((4 + 2 * hi) ^ sw) << 4), o11 = rb + (((5 + 2 * hi) ^ sw) << 4);
  const u32x4 a0 = *(const LAS u32x4*)(Ks + o00), a1 = *(const LAS u32x4*)(Ks + o01), a2 = *(const LAS u32x4*)(Ks + o10), a3 = *(const LAS u32x4*)(Ks + o11);
  const u32x4 b0 = *(const LAS u32x4*)(Ks + 4096 + o00), b1 = *(const LAS u32x4*)(Ks + 4096 + o01), b2 = *(const LAS u32x4*)(Ks + 4096 + o10), b3 = *(const LAS u32x4*)(Ks + 4096 + o11);
  asm volatile("s_waitcnt lgkmcnt(0)" ::: "memory"); SBAR();
#define V8(LO_, HI_) (pg8::v8i){(int)LO_[0], (int)LO_[1], (int)LO_[2], (int)LO_[3], (int)HI_[0], (int)HI_[1], (int)HI_[2], (int)HI_[3]}
  { const pg8::v8i k0 = V8(a0, a1), k1 = V8(a2, a3);
    asm volatile("s_nop 1\n\tv_mfma_f32_32x32x64_f8f6f4 %0, %1, %2, 0\n\tv_mfma_f32_32x32x64_f8f6f4 %0, %3, %4, %0" : "=&v"(p0) : "v"(k0), "v"(q.f[0]), "v"(k1), "v"(q.f[1])); }
  { const pg8::v8i k0 = V8(b0, b1), k1 = V8(b2, b3);
    asm volatile("s_nop 1\n\tv_mfma_f32_32x32x64_f8f6f4 %0, %1, %2, 0\n\tv_mfma_f32_32x32x64_f8f6f4 %0, %3, %4, %0" : "=&v"(p1) : "v"(k0), "v"(q.f[0]), "v"(k1), "v"(q.f[1])); }
#undef V8
  asm volatile("s_nop 7\n\ts_nop 7\n\ts_nop 3" ::: "memory");
}
typedef int v4i_f4 __attribute__((ext_vector_type(4)));
#define PVL(LACC, PA, ONES) asm volatile("s_nop 1\n\tv_mfma_f32_32x32x64_f8f6f4 %0, %1, %2, %0 cbsz:0 blgp:4" : "+v"(LACC) : "v"(PA), "v"(ONES))
__device__ __forceinline__ void pv_d0(f32x16 (&o)[4], const LAS char* Vs, int off0, int off1, const pg8::v8i& pa, f32x16& lacc, const v4i_f4& ones) {
  u32x4 lo[4], hi4[4];
#pragma unroll
  for (int d0 = 0; d0 < 4; ++d0) { lo[d0] = *(const LAS u32x4*)(Vs + d0 * 2048 + off0); hi4[d0] = *(const LAS u32x4*)(Vs + d0 * 2048 + off1); }
  asm volatile("s_waitcnt lgkmcnt(0)" ::: "memory"); SBAR();
#pragma unroll
  for (int d0 = 0; d0 < 4; ++d0) { const pg8::v8i vf = {(int)lo[d0].x, (int)lo[d0].y, (int)lo[d0].z, (int)lo[d0].w, (int)hi4[d0].x, (int)hi4[d0].y, (int)hi4[d0].z, (int)hi4[d0].w};
    asm volatile("s_nop 1\n\tv_mfma_f32_32x32x64_f8f6f4 %0, %1, %2, %0" : "+v"(o[d0]) : "v"(pa), "v"(vf)); }
  PVL(lacc, pa, ones);
}
#define PIN(x) asm volatile("" : "+v"(x))
__device__ __forceinline__ float max3f(float a, float b, float c) { float r; asm("v_max3_f32 %0, %1, %2, %3" : "=v"(r) : "v"(a), "v"(b), "v"(c)); return r; }
__device__ __forceinline__ float max2f(float a, float b) { float r; asm("v_max_f32 %0, %1, %2" : "=v"(r) : "v"(a), "v"(b)); return r; }
__device__ __forceinline__ float max16(const f32x16& p) {
  float m = max3f(p[0], p[1], p[2]);
#pragma unroll
  for (int r = 3; r < 15; r += 2) m = max3f(m, p[r], p[r + 1]);
  return max2f(m, p[15]);
}
struct VF { u32x4 lo[4], hi4[4]; };
__device__ __forceinline__ void vf_load(VF& f, const LAS char* Vs, int off0, int off1) {
#pragma unroll
  for (int d0 = 0; d0 < 4; ++d0) { f.lo[d0] = *(const LAS u32x4*)(Vs + d0 * 2048 + off0); f.hi4[d0] = *(const LAS u32x4*)(Vs + d0 * 2048 + off1); }
}
template <bool PRE  >
__device__ __forceinline__ void pv_psm(f32x16 (&o)[4], const LAS char* Vs, int off0, int off1, const pg8::v8i& pa, VF& vfr,
                                       f32x16& p0, f32x16& p1, float& m_reg, float& mn, float& alpha, const float C, const float thr_raw, const float braw, f32x16& lacc, const v4i_f4& ones) {
  if (!PRE) vf_load(vfr, Vs, off0, off1);
  u32x4 (&lo)[4] = vfr.lo; u32x4 (&hi4)[4] = vfr.hi4;
  SBAR();
#define PV1(d0) do { const pg8::v8i vf = {(int)lo[d0].x, (int)lo[d0].y, (int)lo[d0].z, (int)lo[d0].w, (int)hi4[d0].x, (int)hi4[d0].y, (int)hi4[d0].z, (int)hi4[d0].w}; \
    asm volatile("s_nop 1\n\tv_mfma_f32_32x32x64_f8f6f4 %0, %1, %2, %0" : "+v"(o[d0]) : "v"(pa), "v"(vf)); SBAR(); } while (0)
  PV1(0);
  float mx0 = max16(p0); PIN(mx0); SBAR();
  PV1(1);
  float pmax = max2f(mx0, max16(p1));
  { auto rr = __builtin_amdgcn_permlane32_swap(__float_as_uint(pmax), __float_as_uint(pmax), false, false);
    pmax = max2f(__uint_as_float(rr[0]), __uint_as_float(rr[1])); }
  pmax += braw;
  alpha = 1.f;
  if (__builtin_expect(!__all(pmax - m_reg <= thr_raw), 0)) {
    asm volatile("" ::: "memory");
    const float mnew = max2f(m_reg, pmax); alpha = __builtin_amdgcn_exp2f((m_reg - mnew) * C); m_reg = mnew; }
  mn = m_reg;
  float mnC = (braw - m_reg) * C + PSH; PIN(mnC);
  SBAR();
  PV1(2);
#pragma unroll
  for (int r = 0; r < 16; ++r) p0[r] = fmaf(p0[r], C, mnC);
#pragma unroll
  for (int r = 0; r < 16; ++r) p1[r] = fmaf(p1[r], C, mnC);
  PIN(p0); PIN(p1); SBAR();
  PV1(3);
#pragma unroll
  for (int r = 0; r < 8; ++r) p0[r] = __builtin_amdgcn_exp2f(p0[r]);
  PIN(p0); SBAR();
  PVL(lacc, pa, ones); SBAR();
#pragma unroll
  for (int r = 8; r < 16; ++r) p0[r] = __builtin_amdgcn_exp2f(p0[r]);
  PIN(p0); SBAR();
#undef PV1
}
__device__ __forceinline__ void qkt8_fsm(f32x16& n0, f32x16& n1, const LAS char* Ks, const QF8& q, int r32, int hi,
                                         f32x16& p0, f32x16& p1, pg8::v8i& pa, VF& vfr, const LAS char* Vs, int voff0, int voff1) {
  const int sw = (r32 >> 1) & 7, rb = r32 * 128;
  const int o00 = rb + (((2 * hi) ^ sw) << 4), o01 = rb + (((2 * hi + 1) ^ sw) << 4), o10 = rb + (((4 + 2 * hi) ^ sw) << 4), o11 = rb + (((5 + 2 * hi) ^ sw) << 4);
  const u32x4 a0 = *(const LAS u32x4*)(Ks + o00), a1 = *(const LAS u32x4*)(Ks + o01), a2 = *(const LAS u32x4*)(Ks + o10), a3 = *(const LAS u32x4*)(Ks + o11);
  asm volatile("" ::: "memory"); SBAR();
#define V8(LO_, HI_) (pg8::v8i){(int)LO_[0], (int)LO_[1], (int)LO_[2], (int)LO_[3], (int)HI_[0], (int)HI_[1], (int)HI_[2], (int)HI_[3]}
  { const pg8::v8i k0 = V8(a0, a1); asm volatile("s_nop 1\n\tv_mfma_f32_32x32x64_f8f6f4 %0, %1, %2, 0" : "=&v"(n0) : "v"(k0), "v"(q.f[0])); } SBAR();
  const u32x4 b0 = *(const LAS u32x4*)(Ks + 4096 + o00), b1 = *(const LAS u32x4*)(Ks + 4096 + o01), b2 = *(const LAS u32x4*)(Ks + 4096 + o10), b3 = *(const LAS u32x4*)(Ks + 4096 + o11);
  asm volatile("" ::: "memory"); SBAR();
#pragma unroll
  for (int r = 0; r < 8; ++r) p1[r] = __builtin_amdgcn_exp2f(p1[r]);
  PIN(p1); SBAR();
  { const pg8::v8i k1 = V8(a2, a3); asm volatile("s_nop 1\n\tv_mfma_f32_32x32x64_f8f6f4 %0, %1, %2, %0" : "+v"(n0) : "v"(k1), "v"(q.f[1])); } SBAR();
#pragma unroll
  for (int r = 8; r < 16; ++r) p1[r] = __builtin_amdgcn_exp2f(p1[r]);
  PIN(p1); SBAR();
  { const pg8::v8i k0 = V8(b0, b1); asm volatile("s_nop 1\n\tv_mfma_f32_32x32x64_f8f6f4 %0, %1, %2, 0" : "=&v"(n1) : "v"(k0), "v"(q.f[0])); } SBAR();
  pa[0] = (int)pg8::pk4_fp8_u(p0[0], p0[1], p0[2], p0[3]);   pa[1] = (int)pg8::pk4_fp8_u(p0[4], p0[5], p0[6], p0[7]);
  pa[2] = (int)pg8::pk4_fp8_u(p0[8], p0[9], p0[10], p0[11]); pa[3] = (int)pg8::pk4_fp8_u(p0[12], p0[13], p0[14], p0[15]);
  PIN(pa); SBAR();
  { const pg8::v8i k1 = V8(b2, b3); asm volatile("s_nop 1\n\tv_mfma_f32_32x32x64_f8f6f4 %0, %1, %2, %0" : "+v"(n1) : "v"(k1), "v"(q.f[1])); } SBAR();
#undef V8
  pa[4] = (int)pg8::pk4_fp8_u(p1[0], p1[1], p1[2], p1[3]);   pa[5] = (int)pg8::pk4_fp8_u(p1[4], p1[5], p1[6], p1[7]);
  pa[6] = (int)pg8::pk4_fp8_u(p1[8], p1[9], p1[10], p1[11]); pa[7] = (int)pg8::pk4_fp8_u(p1[12], p1[13], p1[14], p1[15]);
  PIN(pa);
  asm volatile("s_nop 7\n\ts_nop 7" ::: "memory");
}
__device__ __forceinline__ void qkt4_fsm(f32x16& n0, f32x16& n1, const LAS char* Ks, const bf16x8 (&qr)[4], int r32, int hi,
                                         f32x16& p0, f32x16& p1, pg8::v8i& pa) {
  bf16x8 b0[4], b1[4];
#pragma unroll
  for (int d0 = 0; d0 < 2; ++d0) { const int cb = (d0 * 16 + hi * 8) * 2;
    b0[d0] = *(const LAS bf16x8*)(Ks + KSWZ64(r32, cb)); b1[d0] = *(const LAS bf16x8*)(Ks + KSWZ64(32 + r32, cb)); }
  asm volatile("" ::: "memory"); SBAR();
#define MM0(ACC, A_, B_) do { asm volatile("s_nop 1\n\tv_mfma_f32_32x32x16_bf16 %0, %1, %2, 0" : "=&v"(ACC) : "v"(A_), "v"(B_)); SBAR(); } while (0)
#define MM(ACC, A_, B_)  do { asm volatile("s_nop 1\n\tv_mfma_f32_32x32x16_bf16 %0, %1, %2, %0" : "+v"(ACC) : "v"(A_), "v"(B_)); SBAR(); } while (0)
#define EXP4(i0) do { _Pragma("unroll") for (int r = (i0); r < (i0) + 4; ++r) p1[r] = __builtin_amdgcn_exp2f(p1[r]); PIN(p1); SBAR(); } while (0)
  EXP4(0);
  MM0(n0, b0[0], qr[0]); EXP4(4);
  MM0(n1, b1[0], qr[0]);
#pragma unroll
  for (int d0 = 2; d0 < 4; ++d0) { const int cb = (d0 * 16 + hi * 8) * 2;
    b0[d0] = *(const LAS bf16x8*)(Ks + KSWZ64(r32, cb)); b1[d0] = *(const LAS bf16x8*)(Ks + KSWZ64(32 + r32, cb)); }
  asm volatile("" ::: "memory"); SBAR();
  EXP4(8);
  MM(n0, b0[1], qr[1]);  EXP4(12);
  MM(n1, b1[1], qr[1]);
  pa[0] = (int)pg8::pk4_fp8_u(p0[0], p0[1], p0[2], p0[3]);   pa[1] = (int)pg8::pk4_fp8_u(p0[4], p0[5], p0[6], p0[7]);   PIN(pa); SBAR();
  MM(n0, b0[2], qr[2]);
  pa[2] = (int)pg8::pk4_fp8_u(p0[8], p0[9], p0[10], p0[11]); pa[3] = (int)pg8::pk4_fp8_u(p0[12], p0[13], p0[14], p0[15]); PIN(pa); SBAR();
  MM(n1, b1[2], qr[2]);
  pa[4] = (int)pg8::pk4_fp8_u(p1[0], p1[1], p1[2], p1[3]);   pa[5] = (int)pg8::pk4_fp8_u(p1[4], p1[5], p1[6], p1[7]);   PIN(pa); SBAR();
  MM(n0, b0[3], qr[3]);
  pa[6] = (int)pg8::pk4_fp8_u(p1[8], p1[9], p1[10], p1[11]); pa[7] = (int)pg8::pk4_fp8_u(p1[12], p1[13], p1[14], p1[15]); PIN(pa); SBAR();
  MM(n1, b1[3], qr[3]);
  asm volatile("s_nop 7\n\ts_nop 7" ::: "memory");
#undef MM0
#undef MM
#undef EXP4
}
struct QB8 { pg8::v8i f; };
#define KB8_READ(a0, a1, b0, b1) const int sw_ = (r32 >> 2) & 3, rb_ = r32 * 64, o0_ = rb_ + (((2 * hi) ^ sw_) << 4), o1_ = rb_ + (((2 * hi + 1) ^ sw_) << 4); \
  const u32x4 a0 = *(const LAS u32x4*)(Ks + o0_), a1 = *(const LAS u32x4*)(Ks + o1_), b0 = *(const LAS u32x4*)(Ks + 2048 + o0_), b1 = *(const LAS u32x4*)(Ks + 2048 + o1_)
#define V8B(LO_, HI_) (pg8::v8i){(int)LO_[0], (int)LO_[1], (int)LO_[2], (int)LO_[3], (int)HI_[0], (int)HI_[1], (int)HI_[2], (int)HI_[3]}
__device__ __forceinline__ void qktb8(f32x16& p0, f32x16& p1, const LAS char* Ks, const QB8& q, int r32, int hi) {
  KB8_READ(a0, a1, b0, b1);
  asm volatile("s_waitcnt lgkmcnt(0)" ::: "memory"); SBAR();
  { const pg8::v8i k0 = V8B(a0, a1); asm volatile("s_nop 1\n\tv_mfma_f32_32x32x64_f8f6f4 %0, %1, %2, 0" : "=&v"(p0) : "v"(k0), "v"(q.f)); }
  { const pg8::v8i k1 = V8B(b0, b1); asm volatile("s_nop 1\n\tv_mfma_f32_32x32x64_f8f6f4 %0, %1, %2, 0" : "=&v"(p1) : "v"(k1), "v"(q.f)); }
  asm volatile("s_nop 7\n\ts_nop 7\n\ts_nop 7" ::: "memory");
}
__device__ __forceinline__ void qktb8_fsm(f32x16& n0, f32x16& n1, const LAS char* Ks, const QB8& q, int r32, int hi, f32x16& p0, f32x16& p1, pg8::v8i& pa) {
  KB8_READ(a0, a1, b0, b1);
  asm volatile("" ::: "memory"); SBAR();
#pragma unroll
  for (int r = 0; r < 8; ++r) p1[r] = __builtin_amdgcn_exp2f(p1[r]);
  PIN(p1); SBAR();
  { const pg8::v8i k0 = V8B(a0, a1); asm volatile("s_nop 1\n\tv_mfma_f32_32x32x64_f8f6f4 %0, %1, %2, 0" : "=&v"(n0) : "v"(k0), "v"(q.f)); } SBAR();
#pragma unroll
  for (int r = 8; r < 16; ++r) p1[r] = __builtin_amdgcn_exp2f(p1[r]);
  pa[0] = (int)pg8::pk4_fp8_u(p0[0], p0[1], p0[2], p0[3]);   pa[1] = (int)pg8::pk4_fp8_u(p0[4], p0[5], p0[6], p0[7]);
  PIN(p1); PIN(pa); SBAR();
  { const pg8::v8i k1 = V8B(b0, b1); asm volatile("s_nop 1\n\tv_mfma_f32_32x32x64_f8f6f4 %0, %1, %2, 0" : "=&v"(n1) : "v"(k1), "v"(q.f)); } SBAR();
  pa[2] = (int)pg8::pk4_fp8_u(p0[8], p0[9], p0[10], p0[11]); pa[3] = (int)pg8::pk4_fp8_u(p0[12], p0[13], p0[14], p0[15]);
  pa[4] = (int)pg8::pk4_fp8_u(p1[0], p1[1], p1[2], p1[3]);   pa[5] = (int)pg8::pk4_fp8_u(p1[4], p1[5], p1[6], p1[7]);
  pa[6] = (int)pg8::pk4_fp8_u(p1[8], p1[9], p1[10], p1[11]); pa[7] = (int)pg8::pk4_fp8_u(p1[12], p1[13], p1[14], p1[15]);
  PIN(pa);
  asm volatile("s_nop 7\n\ts_nop 7" ::: "memory");
}
#undef KB8_READ
#undef V8B
__device__ __forceinline__ void add_bias(f32x16& p0, f32x16& p1, const LAS float* bt, int base  ) {
  const LAS float* b = bt + base;
#pragma unroll
  for (int r = 0; r < 16; ++r) { const int c = (r & 3) + 8 * (r >> 2); p0[r] += b[c]; p1[r] += b[32 + c]; }
}

template <int ND0, bool BIAS, int SDEPTH, class QT>
__device__ __forceinline__ void attn_core(const QT& qr, const void* __restrict__ Kh  , const unsigned char* __restrict__ Vt  , LAS char* lds,
                                          f32x16 (&o)[4], f32x16& l_out  , const int qw0  , const float bneg, const float bpos,
                                          Frame& F, WC_PARAMS) {
  constexpr float scale = (ND0 == 8) ? 0.088388347648318440f : 0.125f;
  const int tid = opaque_tid(), wid = __builtin_amdgcn_readfirstlane(tid >> 6), lane = tid & 63, r32 = lane & 31, hi = lane >> 5;
  LAS char* V_lds = lds + OFF_V; LAS char* K_lds = lds + OFF_K;
  LAS float* ws = (LAS float*)(lds + OFF_WS) + wid * 64; LAS float* al_l = ws + 32;
  const LAS float* bt = (const LAS float*)(lds + OFF_BT);
  constexpr float C = scale * 1.4426950408889634f, thr_raw = THR / scale;
  const int qpos = qw0 + r32;
  LAS char* wbuf = lds + OFF_OST + wid * 8192;
  wc_q = 0; if (wc_cur < 0) wconv_issue(F, WC_ARGS, wbuf, lane);
  float m_reg = -1e30f; f32x16 lacc = f32x16{};
  const v4i_f4 ones = {0x22222222, 0x22222222, 0x22222222, 0x22222222};
#pragma unroll
  for (int d = 0; d < 4; ++d) o[d] = f32x16{};
  const int sr = tid >> 4, sc = (tid & 15) * 8;
  const int kr64 = tid >> 3, kc64 = (tid & 7) * 8;
  const int vst = (tid >> 2) * 64 + (((tid & 3) ^ ((tid >> 4) & 3)) << 4), kst8 = (tid >> 3) * 128 + (((tid & 7) ^ ((tid >> 4) & 7)) << 4);
  const int kst4 = (tid >> 2) * 64 + (((tid & 3) ^ ((tid >> 4) & 3)) << 4);
  const int vsw = (r32 >> 2) & 3, voff0 = r32 * 64 + (((2 * hi) ^ vsw) << 4), voff1 = r32 * 64 + (((2 * hi + 1) ^ vsw) << 4);
  struct { u32x4 vs0; bf16x8 ks0; } sr_[SDEPTH];
  const unsigned goff = (unsigned)((sr * LDR + sc) * 2), goff64 = (unsigned)((kr64 * LDR + kc64) * 2), gvoff = (unsigned)tid * 16u;
#define SLOAD(i, k0) do { const char* vt = (const char*)Vt + (size_t)((k0) / KVBLK) * 8192; const char* kt = (const char*)Kh + (size_t)(k0) * (LDR * 2); \
    sr_[i].vs0 = *(const u32x4*)(vt + gvoff); \
    if (ND0 == 8) { sr_[i].ks0 = *(const bf16x8*)((const char*)Kh + (size_t)((k0) / KVBLK) * 8192 + gvoff); } \
    else { if (wid < 4) sr_[i].ks0 = *(const bf16x8*)((const char*)Kh + (size_t)((k0) / KVBLK) * 4096 + gvoff); } } while (0)
#define SWRITE(b, i) do { *(LAS u32x4*)(V_lds + (b) * SHM_V + vst) = sr_[i].vs0; \
    if (ND0 == 8) { *(LAS bf16x8*)(K_lds + (b) * SHM_K + kst8) = sr_[i].ks0; } \
    else { *(LAS bf16x8*)(K_lds + (b) * SHM_K + KSWZ64(kr64, kc64 * 2)) = sr_[i].ks0; } } while (0)
#define SWAIT() do { if (SDEPTH == 1) asm volatile("s_waitcnt vmcnt(0)" ::: "memory"); else asm volatile("s_waitcnt vmcnt(2)" ::: "memory"); } while (0)
#define QKT(P0, P1, KS) do { if constexpr (ND0 == 8) qkt8(P0, P1, KS, qr, r32, hi); else qktb8(P0, P1, KS, qr, r32, hi); } while (0)
#define RESC(a) do { if (__any((a) < 1.f)) { if (hi == 0) al_l[r32] = (a); asm volatile("s_waitcnt lgkmcnt(0)" ::: "memory"); \
    _Pragma("unroll") for (int d = 0; d < 4; ++d) _Pragma("unroll") for (int r = 0; r < 16; ++r) o[d][r] *= al_l[crow(r, hi)]; } } while (0)
#define TBIAS(P0, P1, k0, BR) do { BR = 0.f; if (BIAS) { const int klo = (k0) - qw0; \
    if (klo - 31 >= 91) BR = bpos; else if (klo + 63 <= -91) BR = bneg; else add_bias(P0, P1, bt, (k0) - qpos + 256 + 4 * hi); } } while (0)
  f32x16 pA0, pA1, pB0, pB1; float mnA, mnB, alA, alB, br; pg8::v8i pa; constexpr int NT = SEQ / KVBLK;
#define SWRITE3(sl, i) do { *(LAS u32x4*)(V_lds + (sl) * 8192 + vst) = sr_[i].vs0; \
    if (ND0 == 8) { *(LAS bf16x8*)(K_lds + (sl) * 8192 + kst8) = sr_[i].ks0; } \
    else { if (wid < 4) *(LAS bf16x8*)(K_lds + (sl) * 8192 + kst4) = sr_[i].ks0; } } while (0)
#define NEXT3(x) ((x) == 2 ? 0 : (x) + 1)
#define RESC3(a) do { if (__any((a) < 1.f)) { if (hi == 0) al_l[r32] = (a); asm volatile("s_nop 7\n\ts_nop 7\n\ts_nop 7\n\ts_waitcnt lgkmcnt(0)" ::: "memory"); \
    _Pragma("unroll") for (int r = 0; r < 16; ++r) { const float a_ = al_l[crow(r, hi)]; lacc[r] *= a_; _Pragma("unroll") for (int d = 0; d < 4; ++d) o[d][r] *= a_; } } } while (0)
#define QKT_FSM(N0, N1, KS, P0, P1, AL, VS) do { if constexpr (ND0 == 8) qkt8_fsm(N0, N1, KS, qr, r32, hi, P0, P1, pa, vfr, VS, voff0, voff1); else qktb8_fsm(N0, N1, KS, qr, r32, hi, P0, P1, pa); } while (0)
  VF vfr; constexpr bool PRE = false;
  SLOAD(0, 0); SLOAD(1, KVBLK); asm volatile("s_waitcnt vmcnt(0)" ::: "memory");
  __syncthreads();
  SWRITE3(0, 0); SWRITE3(1, 1); SLOAD(0, 2 * KVBLK);
  wconv_step(F, WC_ARGS, wbuf, lane, false); __syncthreads();
  QKT(pA0, pA1, K_lds); TBIAS(pA0, pA1, 0, br); partialSM(pA0, pA1, m_reg, mnA, alA, C, thr_raw, br);
  int ks = 1, vs = 0, wsl = 2;
#define STAGE3(jj) do { if ((jj) + 2 < NT) { asm volatile("s_waitcnt vmcnt(0)" ::: "memory"); SWRITE3(wsl, 0); } if ((jj) + 3 < NT) SLOAD(0, ((jj) + 3) * KVBLK); \
    wconv_step(F, WC_ARGS, wbuf, lane, (jj) + 2 >= NT); } while (0)
#define STEP(jj, N0, N1, mnN, alN, P0, P1, alP) do { \
    SBAR(); if (wid >= 4) { STAGE3(jj); } SBAR(); \
    QKT_FSM(N0, N1, K_lds + ks * 8192, P0, P1, alP, V_lds + vs * 8192); SBAR(); \
    TBIAS(N0, N1, ((jj) + 1) * KVBLK, br); pv_psm<PRE>(o, V_lds + vs * 8192, voff0, voff1, pa, vfr, N0, N1, m_reg, mnN, alN, C, thr_raw, br, lacc, ones); \
    RESC3(alN); SBAR(); if (wid < 4) { STAGE3(jj); } SBAR(); __syncthreads(); \
    ks = NEXT3(ks); vs = NEXT3(vs); wsl = NEXT3(wsl); } while (0)
  for (int j = 0; j + 2 < NT; j += 2) {
    STEP(j, pB0, pB1, mnB, alB, pA0, pA1, alA);
    STEP(j + 1, pA0, pA1, mnA, alA, pB0, pB1, alB);
  }
  STEP(NT - 2, pB0, pB1, mnB, alB, pA0, pA1, alA);
  finishSM(pB0, pB1, pa); SBAR();
  pv_d0(o, V_lds + vs * 8192, voff0, voff1, pa, lacc, ones);
  asm volatile("s_nop 7\n\ts_nop 7\n\ts_nop 7" ::: "memory");
  l_out = lacc;
#undef SLOAD
#undef SWRITE
#undef SWAIT
#undef QKT
#undef RESC
#undef TBIAS
#undef QKT_FSM
#undef SWRITE3
#undef NEXT3
#undef RESC3
#undef STEP
#undef STAGE3
}
__device__ __forceinline__ void row_rcp(float l_reg, LAS char* lds, float (&rli)[16]) {
  const int tid = opaque_tid(), wid = __builtin_amdgcn_readfirstlane(tid >> 6), lane = tid & 63, r32 = lane & 31, hi = lane >> 5;
  LAS float* li_l = (LAS float*)(lds + OFF_WS) + wid * 64;
  if (hi == 0) li_l[r32] = l_reg; asm volatile("s_waitcnt lgkmcnt(0)" ::: "memory");
#pragma unroll
  for (int r = 0; r < 16; ++r) rli[r] = __builtin_amdgcn_rcpf(li_l[crow(r, hi)]);
  asm volatile("s_waitcnt lgkmcnt(0)" ::: "memory");
}
constexpr float AO_SCALE = 16.f;
__device__ __forceinline__ void stage_store(const f32x16 (&o)[4], LAS char* lds, unsigned char* Ow  ) {
  const int tid = opaque_tid(), wid = __builtin_amdgcn_readfirstlane(tid >> 6), lane = tid & 63, r32 = lane & 31, hi = lane >> 5;
  LAS char* ost = lds + OFF_OST + wid * 8192;
  LAS unsigned char* wb = (LAS unsigned char*)(ost + hi * 512 + r32);
#pragma unroll
  for (int r = 0; r < 16; ++r)
#pragma unroll
    for (int d0 = 0; d0 < 4; ++d0) wb[((r & 3) + 8 * (r >> 2)) * 128 + d0 * 32] = (unsigned char)(__builtin_amdgcn_cvt_pk_fp8_f32(o[d0][r] * AO_SCALE, 0.f, 0, false) & 0xffu);
  asm volatile("s_waitcnt lgkmcnt(0)" ::: "memory");
#pragma unroll 1
  for (int i = 0; i < 4; ++i) { const int row = (lane >> 3) + 8 * i; const u32x4 v = *(const LAS u32x4*)(ost + row * 128 + (lane & 7) * 16);
    *(u32x4*)(Ow + (size_t)row * DM + (lane & 7) * 16) = v; }
  asm volatile("s_waitcnt lgkmcnt(0)" ::: "memory");
}
}

__device__ __forceinline__ void transpose_item(const float* W, int K, int N, bf16* WT, int k0, int n0, int orow0, LAS float* scr, int lane) {
#pragma unroll 8
    for (int i = 0; i < 32; ++i) { const int kk = 2 * i + (lane >> 5); scr[kk * 33 + (lane & 31)] = W[(size_t)(k0 + kk) * N + n0 + (lane & 31)]; }
    LDS_WAIT(); asm volatile("" ::: "memory");
    const int c = lane & 7;
#pragma unroll
    for (int j = 0; j < 4; ++j) { const int n = (lane >> 3) + 8 * j; const LAS float* s = scr + (8 * c) * 33 + n;
        u32x4 o; o.x = pk2(s[0 * 33], s[1 * 33]); o.y = pk2(s[2 * 33], s[3 * 33]); o.z = pk2(s[4 * 33], s[5 * 33]); o.w = pk2(s[6 * 33], s[7 * 33]);
        *(GAS u32x4*)(WT + (size_t)(orow0 + n) * K + k0 + 8 * c) = o; }
    LDS_WAIT(); asm volatile("" ::: "memory");
}
__device__ __forceinline__ void transpose_item_f8(const float* W, int K, int N, unsigned char* WT, int k0, int n0, int orow0, LAS float* scr, int lane) {
#pragma unroll 8
    for (int i = 0; i < 32; ++i) { const int kk = 2 * i + (lane >> 5); scr[kk * 33 + (lane & 31)] = W[(size_t)(k0 + kk) * N + n0 + (lane & 31)]; }
    LDS_WAIT(); asm volatile("" ::: "memory");
    const int c = lane & 7; constexpr float q = pg8::WQ_SCALE;
#pragma unroll
    for (int j = 0; j < 4; ++j) { const int n = (lane >> 3) + 8 * j; const LAS float* s = scr + (8 * c) * 33 + n;
        u32x2 o; o.x = pg8::pk4_fp8(s[0 * 33] * q, s[1 * 33] * q, s[2 * 33] * q, s[3 * 33] * q); o.y = pg8::pk4_fp8(s[4 * 33] * q, s[5 * 33] * q, s[6 * 33] * q, s[7 * 33] * q);
        *(GAS u32x2*)(WT + (size_t)(orow0 + n) * K + k0 + 8 * c) = o; }
    LDS_WAIT(); asm volatile("" ::: "memory");
}
__device__ __forceinline__ int t5_bucket(int rp) {
    const int n = rp < 0 ? -rp : rp; int b;
    if (n < 8) b = n; else { const int j = (31 - __builtin_clz((unsigned)(n * n))) - 6; b = 8 + j; if (b > 15) b = 15; }
    return b + (rp > 0 ? 16 : 0);
}
__device__ __forceinline__ void p0_mod_tables(Frame& F) {
    LAS float* sc = (LAS float*)F.lds;
    LAS float* red = (LAS float*)(F.lds + 32768);
    const int tid = F.tid;
    float* mod = (float*)(F.ws + WS_MOD);
    bool did = false;
    for (int unit = F.vcu; unit < 192; unit += F.G) {
        if (!did) { for (int i = tid; i < NB * DM; i += NTHR) { const float v = F.c[i]; sc[i] = v / (1.f + expf(-v)); } __syncthreads(); did = true; }
        const int n0 = unit * 64, l16 = tid & 15, kr = tid >> 4;
        f32x4 acc[4];
#pragma unroll
        for (int b = 0; b < 4; ++b) acc[b] = (f32x4){0.f, 0.f, 0.f, 0.f};
#pragma unroll 16
        for (int j = 0; j < 64; ++j) { const int k = kr + 32 * j; const f32x4 w = *(const f32x4*)(F.w_ada + (size_t)k * (6 * DM) + n0 + l16 * 4);
#pragma unroll
            for (int b = 0; b < 4; ++b) acc[b] += w * sc[b * DM + k]; }
#pragma unroll
        for (int b = 0; b < 4; ++b) *(LAS f32x4*)(red + (kr * 4 + b) * 64 + l16 * 4) = acc[b];
        __syncthreads();
        if (tid < 256) { const int b = tid >> 6, col = tid & 63; float s = 0.f;
#pragma unroll 8
            for (int q = 0; q < 32; ++q) s += red[(q * 4 + b) * 64 + col];
            mod[b * 6 * DM + n0 + col] = s + F.b_ada[n0 + col]; }
        __syncthreads();
    }
    if (F.vcu == (192 % F.G)) {
        float* rope = (float*)(F.ws + WS_ROPE);
        for (int i = tid; i < 2048; i += NTHR) { const int pos = i >> 5, f = i & 31; const double inv = pow(10000.0, -(double)(2 * f) / 64.0), ang = (double)pos * inv;
            rope[i] = (float)cos(ang); rope[2048 + i] = (float)sin(ang); }
    }
    if (F.vcu == (193 % F.G)) {
        float* bt = (float*)(F.ws + WS_BIAS);
        for (int i = tid; i < 8 * 512; i += NTHR) { const int h = i >> 9, rel = (i & 511) - 256; bt[i] = F.relb[t5_bucket(rel) * 8 + h] * 8.f; }
    }
    if (F.vcu == (194 % F.G) && tid == 0) {
        float s1 = 0.f, s2 = 0.f; for (int i = 0; i < 64; ++i) { s1 += F.lq1[i] * F.lk1[i]; s2 += F.lq2[i] * F.lk2[i]; }
        ((float*)(F.ws + WS_MISC))[0] = expf(s1) - expf(s2) + 0.2f;
    }
}
__device__ __forceinline__ void witem_load(const WItem& d, f32x4 (&v)[8], int lane) {
    const float* p = d.src + (size_t)(lane >> 3) * d.N + (lane & 7) * 4;
#pragma unroll
    for (int i = 0; i < 8; ++i) v[i] = __builtin_nontemporal_load((const f32x4*)(p + (size_t)(8 * i) * d.N));
}
__device__ __forceinline__ void witem_finish(const WItem& d, const f32x4 (&v)[8], LAS float* scr, int lane) {
#pragma unroll
    for (int i = 0; i < 8; ++i) { LAS float* q = scr + (8 * i + (lane >> 3)) * 33 + (lane & 7) * 4; q[0] = v[i].x; q[1] = v[i].y; q[2] = v[i].z; q[3] = v[i].w; }
    LDS_WAIT(); asm volatile("" ::: "memory");
    const int c = lane & 7;
    if (d.f8) { constexpr float q = pg8::WQ_SCALE;
#pragma unroll
        for (int j = 0; j < 4; ++j) { const int n = (lane >> 3) + 8 * j; const LAS float* s = scr + (8 * c) * 33 + n;
            u32x2 o; o.x = pg8::pk4_fp8(s[0 * 33] * q, s[1 * 33] * q, s[2 * 33] * q, s[3 * 33] * q); o.y = pg8::pk4_fp8(s[4 * 33] * q, s[5 * 33] * q, s[6 * 33] * q, s[7 * 33] * q);
            *(GAS u32x2*)(d.dst + (size_t)n * d.pitch + 8 * c) = o; }
    } else {
#pragma unroll
        for (int j = 0; j < 4; ++j) { const int n = (lane >> 3) + 8 * j; const LAS float* s = scr + (8 * c) * 33 + n;
            u32x4 o; o.x = pk2(s[0 * 33], s[1 * 33]); o.y = pk2(s[2 * 33], s[3 * 33]); o.z = pk2(s[4 * 33], s[5 * 33]); o.w = pk2(s[6 * 33], s[7 * 33]);
            *(GAS u32x4*)(d.dst + (size_t)n * d.pitch + 16 * c) = o; }
    }
    LDS_WAIT(); asm volatile("" ::: "memory");
}
__device__ __forceinline__ void p0_weights_strided(Frame& F, int it, int hi, int stride = 0) {
    LAS float* scr = (LAS float*)(F.lds + 65536 + F.wave * 8704);
    const int NGW = stride ? stride : F.G * NWAVES, lane = opaque_tid() & 63;
    if (it >= hi) return;
    WItem da, db; f32x4 va[8], vb[8];
    witem_decode(F, it, da); witem_load(da, va, lane);
    for (;;) {
        const int itn = it + NGW; const bool hasn = itn < hi;
        if (hasn) { witem_decode(F, itn, db); witem_load(db, vb, lane); }
        witem_finish(da, va, scr, lane);
        if (!hasn) break;
        it = itn + NGW; const bool has2 = it < hi;
        if (has2) { witem_decode(F, it, da); witem_load(da, va, lane); }
        witem_finish(db, vb, scr, lane);
        if (!has2) break;
    }
}

__device__ __forceinline__ void p0_weights(Frame& F, int lo, int hi) { p0_weights_strided(F, lo + F.vcu * NWAVES + F.wave, hi); }
__device__ __forceinline__ void p1_h1(Frame& F) {
    const int gw = F.vcu * NWAVES + F.wave, NGW = F.G * NWAVES, lane = F.lane;
    const float* mod = (const float*)(F.ws + WS_MOD); unsigned char* H = F.ws + WS_H;
    {
        float* wrp = (float*)(F.ws + WS_WRP); float* rcst = (float*)(F.ws + WS_RCST);
        for (int i = (int)blockIdx.x * NTHR + F.tid; i < NB * DM * NE / 4; i += F.G * NTHR) { const int b = i / (DM * NE / 4), r = i % (DM * NE / 4), k = r / (NE / 4);
            const float f = F.norm_ffn[k] * (mod[b * 6 * DM + 4 * DM + k] + 1.f);
            *(f32x4*)(wrp + (size_t)i * 4) = *(const f32x4*)(F.w_router + (size_t)r * 4) * f; }
        if ((int)blockIdx.x < NB * NE) { const int b = (int)blockIdx.x >> 5, e = (int)blockIdx.x & 31;
            LAS float* part = (LAS float*)F.lds; float a = 0.f;
#pragma unroll
            for (int q = 0; q < 4; ++q) { const int k = q * NTHR + F.tid; a += mod[b * 6 * DM + 3 * DM + k] * F.w_router[(size_t)k * NE + e]; }
            a = wave_sum(a); if (F.lane == 0) part[F.wave] = a; __syncthreads();
            if (F.tid == 0) { float t = F.b_router[e];
#pragma unroll
                for (int q = 0; q < NWAVES; ++q) t += part[q];
                rcst[b * 32 + e] = t; }
            __syncthreads(); }
    }
    for (int blk = gw; blk < T / 8; blk += NGW) {
        const int row0 = blk * 8, b = row0 / SEQ;
        f32x4 gm[8], sh[8];
#pragma unroll
        for (int j = 0; j < 8; ++j) { const int col = (lane + 64 * j) * 4; const f32x4 nw = *(const f32x4*)(F.norm_attn + col), scv = *(const f32x4*)(mod + b * 6 * DM + DM + col);
            gm[j] = nw * (scv + 1.f); sh[j] = *(const f32x4*)(mod + b * 6 * DM + col); }
        for (int rr = 0; rr < 8; ++rr) { const int row = row0 + rr;
            const GAS f32x4* xr = (const GAS f32x4*)(F.x + (size_t)row * DM) + lane;
            f32x4 v[8]; float s = 0.f;
#pragma unroll
            for (int j = 0; j < 8; ++j) { v[j] = xr[64 * j]; s += (v[j].x * v[j].x + v[j].y * v[j].y) + (v[j].z * v[j].z + v[j].w * v[j].w); }
            const float rstd = 1.f / sqrtf(wave_sum(s) * (1.f / DM) + EPS);
            GAS unsigned* o4 = (GAS unsigned*)(H + (size_t)row * DM) + lane;
#pragma unroll
            for (int j = 0; j < 8; ++j) { const f32x4 y = v[j] * rstd * gm[j] + sh[j]; o4[64 * j] = pg8::pk4_fp8(y.x, y.y, y.z, y.w); }
        }
    }
}

__device__ __forceinline__ void p2b_knorm(Frame& F) {
    const int gw = F.vcu * NWAVES + F.wave, NGW = F.G * NWAVES, lane = F.lane;
    bf16* P = (bf16*)(F.ws + WS_PROJ); const float* rope = (const float*)(F.ws + WS_ROPE);
    const int ea = (lane & 31) * 4, pa = ea >> 1;
    const f32x4 gka = *(const f32x4*)(F.a_k_norm + ea);
    const int eb = (lane & 3) * 16;
    f32x4 gkb[4];
#pragma unroll
    for (int q = 0; q < 4; ++q) gkb[q] = *(const f32x4*)(F.b_k_norm + eb + 4 * q);
    for (int row = gw; row < T; row += NGW) {
        const int s = row % SEQ, srow = s >> 6, scol = s & 63;
        bf16* pr = P + (size_t)row * INW;
        { GAS u32x2* p = (GAS u32x2*)(pr + COL_KA) + lane; const u32x2 w = *p;
          float v0 = bflo(w.x), v1 = bfhi(w.x), v2 = bflo(w.y), v3 = bfhi(w.y);
          float ss = v0 * v0 + v1 * v1 + v2 * v2 + v3 * v3;
#pragma unroll
          for (int o = 1; o < 32; o <<= 1) ss += __shfl_xor(ss, o);
          const float rstd = 1.f / sqrtf(ss * (1.f / 128.f) + EPS);
          v0 *= rstd * gka.x; v1 *= rstd * gka.y; v2 *= rstd * gka.z; v3 *= rstd * gka.w;
          const int ti = (pa < 32) ? (srow * 32 + pa) : (scol * 32 + pa - 32);
          const float c0 = rope[ti], s0 = rope[2048 + ti], c1 = rope[ti + 1], s1 = rope[2048 + ti + 1];
          *(GAS unsigned*)(F.ws + WS_KA8 + (size_t)(((row / SEQ) * 2 + (lane >> 5)) * 64 + (s >> 6)) * 8192 + (s & 63) * 128 + (lane & 31) * 4) =
              pg8::pk4_fp8(v0 * c0 - v1 * s0, v0 * s0 + v1 * c0, v2 * c1 - v3 * s1, v2 * s1 + v3 * c1); }
        { GAS u32x4* p = (GAS u32x4*)(pr + COL_KB) + lane * 2; const u32x4 w0 = p[0], w1 = p[1];
          float v[16]; v[0] = bflo(w0.x); v[1] = bfhi(w0.x); v[2] = bflo(w0.y); v[3] = bfhi(w0.y); v[4] = bflo(w0.z); v[5] = bfhi(w0.z); v[6] = bflo(w0.w); v[7] = bfhi(w0.w);
          v[8] = bflo(w1.x); v[9] = bfhi(w1.x); v[10] = bflo(w1.y); v[11] = bfhi(w1.y); v[12] = bflo(w1.z); v[13] = bfhi(w1.z); v[14] = bflo(w1.w); v[15] = bfhi(w1.w);
          float ss = 0.f;
#pragma unroll
          for (int q = 0; q < 16; ++q) ss += v[q] * v[q];
          ss += __shfl_xor(ss, 1); ss += __shfl_xor(ss, 2);
          const float rstd = 1.f / sqrtf(ss * (1.f / 64.f) + EPS);
#pragma unroll
          for (int q = 0; q < 16; ++q) v[q] *= rstd * gkb[q >> 2][q & 3];
          u32x4 o8; o8.x = pg8::pk4_fp8(v[0], v[1], v[2], v[3]); o8.y = pg8::pk4_fp8(v[4], v[5], v[6], v[7]); o8.z = pg8::pk4_fp8(v[8], v[9], v[10], v[11]); o8.w = pg8::pk4_fp8(v[12], v[13], v[14], v[15]);
          *(GAS u32x4*)(F.ws + WS_KB8 + (size_t)((((row / SEQ) * 16 + (lane >> 2)) * 64 + (s >> 6))) * 4096 + (s & 63) * 64 + (lane & 3) * 16) = o8; }
    }
    for (int item = gw; item < NB * 10 * 64; item += NGW) {
        const int tile = item & 63, bh = item >> 6, hd = bh % 10, b = bh / 10;
        const int col0 = (hd < 2) ? (COL_VA + hd * 128) : (COL_VB + (hd - 2) * 128);
        const bf16* src = P + (size_t)(b * SEQ + tile * 64) * INW + col0 + 2 * lane;
        unsigned w0[16], w1[16];
#pragma unroll
        for (int g = 0; g < 4; ++g) { unsigned v[16];
#pragma unroll
            for (int t = 0; t < 16; ++t) v[t] = *(const unsigned*)(src + (size_t)(16 * g + t) * INW);
            w0[2 * g]     = pg8::pk4_fp8(bflo(v[0]), bflo(v[1]), bflo(v[2]), bflo(v[3]));     w0[2 * g + 1]     = pg8::pk4_fp8(bflo(v[8]), bflo(v[9]), bflo(v[10]), bflo(v[11]));
            w0[8 + 2 * g] = pg8::pk4_fp8(bflo(v[4]), bflo(v[5]), bflo(v[6]), bflo(v[7]));     w0[8 + 2 * g + 1] = pg8::pk4_fp8(bflo(v[12]), bflo(v[13]), bflo(v[14]), bflo(v[15]));
            w1[2 * g]     = pg8::pk4_fp8(bfhi(v[0]), bfhi(v[1]), bfhi(v[2]), bfhi(v[3]));     w1[2 * g + 1]     = pg8::pk4_fp8(bfhi(v[8]), bfhi(v[9]), bfhi(v[10]), bfhi(v[11]));
            w1[8 + 2 * g] = pg8::pk4_fp8(bfhi(v[4]), bfhi(v[5]), bfhi(v[6]), bfhi(v[7]));     w1[8 + 2 * g + 1] = pg8::pk4_fp8(bfhi(v[12]), bfhi(v[13]), bfhi(v[14]), bfhi(v[15])); }
        GAS u32x4* dst = (GAS u32x4*)(F.ws + WS_VT + (size_t)item * 8192 + (size_t)lane * 128);
#pragma unroll
        for (int q = 0; q < 4; ++q) { dst[q] = (u32x4){w0[4 * q], w0[4 * q + 1], w0[4 * q + 2], w0[4 * q + 3]}; dst[4 + q] = (u32x4){w1[4 * q], w1[4 * q + 1], w1[4 * q + 2], w1[4 * q + 3]}; }
    }
}

__device__ __forceinline__ void attn_unit_A(Frame& F, int ua, WC_PARAMS) {
    const int qb = ua & 15, g = (ua >> 4) & 3, kvh = (ua >> 6) & 1, b = ua >> 7, hq = kvh * 4 + g;
    const int tid = opaque_tid(), wid = F.wave, lane = tid & 63, r32 = lane & 31, hi = lane >> 5;
    const bf16* P = opaque_sptr((const bf16*)(F.ws + WS_PROJ)); const float* rope = (const float*)(F.ws + WS_ROPE);
    const int s = qb * 256 + wid * 32 + r32, row = b * SEQ + s, srow = s >> 6, scol = s & 63;
    attn::QF8 qr;
    { const bf16* qp = P + (size_t)row * INW + COL_QA + hq * 128 + hi * 32;
      u32x4 raw[2][4]; float ss = 0.f;
#pragma unroll
      for (int db = 0; db < 2; ++db)
#pragma unroll
        for (int c = 0; c < 4; ++c) { raw[db][c] = *(const u32x4*)(qp + db * 64 + c * 8);
#pragma unroll
          for (int q = 0; q < 4; ++q) { const float a = bflo(raw[db][c][q]), cc = bfhi(raw[db][c][q]); ss += a * a + cc * cc; } }
      { auto rr = __builtin_amdgcn_permlane32_swap(__float_as_uint(ss), __float_as_uint(ss), false, false); ss = __uint_as_float(rr[0]) + __uint_as_float(rr[1]); }
      const float rstd = 1.f / sqrtf(ss * (1.f / 128.f) + EPS);
#pragma unroll
      for (int db = 0; db < 2; ++db)
#pragma unroll
        for (int c = 0; c < 4; ++c) { const int e0 = db * 64 + hi * 32 + c * 8;
          const f32x4 g0 = *(const f32x4*)(F.a_q_norm + e0), g1 = *(const f32x4*)(F.a_q_norm + e0 + 4);
          const int ti = (db == 0 ? srow : scol) * 32 + hi * 16 + c * 4;
          const f32x4 cs = *(const f32x4*)(rope + ti), sn = *(const f32x4*)(rope + 2048 + ti);
          const u32x4 rw = raw[db][c];
          float v[8]; v[0] = bflo(rw.x) * rstd * g0.x; v[1] = bfhi(rw.x) * rstd * g0.y; v[2] = bflo(rw.y) * rstd * g0.z; v[3] = bfhi(rw.y) * rstd * g0.w;
          v[4] = bflo(rw.z) * rstd * g1.x; v[5] = bfhi(rw.z) * rstd * g1.y; v[6] = bflo(rw.w) * rstd * g1.z; v[7] = bfhi(rw.w) * rstd * g1.w;
          qr.f[db][2 * c]     = (int)pg8::pk4_fp8(v[0] * cs.x - v[1] * sn.x, v[0] * sn.x + v[1] * cs.x, v[2] * cs.y - v[3] * sn.y, v[2] * sn.y + v[3] * cs.y);
          qr.f[db][2 * c + 1] = (int)pg8::pk4_fp8(v[4] * cs.z - v[5] * sn.z, v[4] * sn.z + v[5] * cs.z, v[6] * cs.w - v[7] * sn.w, v[6] * sn.w + v[7] * cs.w); } }
    const unsigned char* Kh = F.ws + WS_KA8 + (size_t)((b * 2 + kvh) * 64) * 8192; const unsigned char* Vh = F.ws + WS_VT + (size_t)((b * 10 + kvh) * 64) * 8192;
    f32x16 o[4]; f32x16 l;
    attn::attn_core<8, false, 2>(qr, Kh, Vh, (LAS char*)F.lds, o, l, qb * 256 + wid * 32, 0.f, 0.f, F, WC_ARGS);
    float rli[16];
#pragma unroll
    for (int r = 0; r < 16; ++r) rli[r] = __builtin_amdgcn_rcpf(l[r]);
#pragma unroll
    for (int d0 = 0; d0 < 4; ++d0)
#pragma unroll
        for (int r = 0; r < 16; ++r) o[d0][r] *= rli[r];
    attn::stage_store(o, (LAS char*)F.lds, F.ws + WS_AO + (size_t)(b * SEQ + qb * 256 + wid * 32) * DM + hq * 128);
}
__device__ __forceinline__ void attn_unit_B(Frame& F, int ub, WC_PARAMS) {
    const int qb = ub & 15, h = (ub >> 4) & 7, b = ub >> 7;
    const int tid = opaque_tid(), wid = F.wave, lane = tid & 63, r32 = lane & 31, hi = lane >> 5;
    const bf16* P = opaque_sptr((const bf16*)(F.ws + WS_PROJ));
    const int s = qb * 256 + wid * 32 + r32, row = b * SEQ + s;
    const float* btg = (const float*)(F.ws + WS_BIAS) + h * 512;
    ((LAS float*)(F.lds + attn::OFF_BT))[tid] = btg[tid];
    const float bneg = __builtin_bit_cast(float, __builtin_amdgcn_readfirstlane(__builtin_bit_cast(int, btg[0])));
    const float bpos = __builtin_bit_cast(float, __builtin_amdgcn_readfirstlane(__builtin_bit_cast(int, btg[511])));
    const float lam = __builtin_bit_cast(float, __builtin_amdgcn_readfirstlane(__builtin_bit_cast(int, ((const float*)(F.ws + WS_MISC))[0])));
    float* stash = (float*)(F.ws + WS_STASH) + (size_t)blockIdx.x * (64 * 512);
    const unsigned char* Vh = F.ws + WS_VT + (size_t)((b * 10 + 2 + h) * 64) * 8192;
    for (int map = 0; map < 2; ++map) {
        attn::QB8 qr;
        { const int tq = opaque_tid(), hi = (tq >> 5) & 1, row = b * SEQ + qb * 256 + wid * 32 + (tq & 31);
          const bf16* qp = P + (size_t)row * INW + COL_QB + h * 128 + map * 64 + hi * 32;
          u32x4 raw[4]; float ss = 0.f;
#pragma unroll
          for (int j = 0; j < 4; ++j) { raw[j] = *(const u32x4*)(qp + j * 8);
#pragma unroll
            for (int q = 0; q < 4; ++q) { const float a = bflo(raw[j][q]), c = bfhi(raw[j][q]); ss += a * a + c * c; } }
          { auto rr = __builtin_amdgcn_permlane32_swap(__float_as_uint(ss), __float_as_uint(ss), false, false); ss = __uint_as_float(rr[0]) + __uint_as_float(rr[1]); }
          const float rstd = 1.f / sqrtf(ss * (1.f / 64.f) + EPS);
#pragma unroll
          for (int j = 0; j < 4; ++j) { const int e0 = hi * 32 + j * 8;
            const f32x4 g0 = *(const f32x4*)(F.b_q_norm + e0), g1 = *(const f32x4*)(F.b_q_norm + e0 + 4);
            qr.f[2 * j]     = (int)pg8::pk4_fp8(bflo(raw[j].x) * rstd * g0.x, bfhi(raw[j].x) * rstd * g0.y, bflo(raw[j].y) * rstd * g0.z, bfhi(raw[j].y) * rstd * g0.w);
            qr.f[2 * j + 1] = (int)pg8::pk4_fp8(bflo(raw[j].z) * rstd * g1.x, bfhi(raw[j].z) * rstd * g1.y, bflo(raw[j].w) * rstd * g1.z, bfhi(raw[j].w) * rstd * g1.w); } }
        const unsigned char* Kh = F.ws + WS_KB8 + (size_t)((b * 16 + h * 2 + map) * 64) * 4096;
        f32x16 o[4]; f32x16 l;
        attn::attn_core<4, true, 2>(qr, Kh, Vh, (LAS char*)F.lds, o, l, qb * 256 + wid * 32, bneg, bpos, F, WC_ARGS);
        float rli[16];
#pragma unroll
        for (int r = 0; r < 16; ++r) rli[r] = __builtin_amdgcn_rcpf(l[r]);
        const int tid = opaque_tid(), r32 = tid & 31;
        if (map == 0) {
#pragma unroll
            for (int d0 = 0; d0 < 4; ++d0)
#pragma unroll
                for (int r = 0; r < 16; r += 4) *(f32x4*)(stash + tid * 64 + d0 * 16 + r) = (f32x4){o[d0][r] * rli[r], o[d0][r + 1] * rli[r + 1], o[d0][r + 2] * rli[r + 2], o[d0][r + 3] * rli[r + 3]};
        } else {
            float ssq[16];
#pragma unroll
            for (int r = 0; r < 16; ++r) ssq[r] = 0.f;
#pragma unroll
            for (int d0 = 0; d0 < 4; ++d0)
#pragma unroll
                for (int r = 0; r < 16; r += 4) { const f32x4 sv = *(const f32x4*)(stash + tid * 64 + d0 * 16 + r);
#pragma unroll
                    for (int q = 0; q < 4; ++q) { const float v = sv[q] - lam * (o[d0][r + q] * rli[r + q]); o[d0][r + q] = v; ssq[r + q] += v * v; } }
#pragma unroll
            for (int r = 0; r < 16; ++r) {
#pragma unroll
                for (int m = 1; m < 32; m <<= 1) ssq[r] += __shfl_xor(ssq[r], m);
                ssq[r] = (1.f / sqrtf(ssq[r] * (1.f / 128.f) + EPS)) * 0.8f; }
            float sg[4];
#pragma unroll
            for (int d0 = 0; d0 < 4; ++d0) sg[d0] = F.b_subln[d0 * 32 + r32];
#pragma unroll
            for (int r = 0; r < 16; ++r)
#pragma unroll
                for (int d0 = 0; d0 < 4; ++d0) o[d0][r] *= ssq[r] * sg[d0];
            attn::stage_store(o, (LAS char*)F.lds, F.ws + WS_AO + (size_t)(b * SEQ + qb * 256 + wid * 32) * DM + 1024 + h * 128);
        }
    }
}
__device__ __forceinline__ void p0_weights_strided(Frame& F, int it, int hi, int stride);
__device__ __forceinline__ void p3_attention(Frame& F) {
    int wc_it = P0_ITEMS_A + F.vcu * NWAVES + F.wave, wc_cur = -1, wc_q = 0;
    for (int ub = F.vcu; ub < NB * 8 * 16; ub += F.G) attn_unit_B(F, ub, WC_ARGS);
    for (int ua = F.vcu; ua < NB * 8 * 16; ua += F.G) attn_unit_A(F, ua, WC_ARGS);
    __syncthreads();
    p0_weights_strided(F, wc_it, P0_ITEMS_ALL, 0);
}

__device__ __forceinline__ void p5_router(Frame& F) {
    constexpr int AST = 68;
    LAS float* Abuf = (LAS float*)F.lds;
    LAS float* Wbuf = (LAS float*)(F.lds + 34816);
    LAS float* shb  = (LAS float*)(F.lds + 51200);
    LAS float* red  = (LAS float*)(F.lds + 53248);
    LAS float* lg   = (LAS float*)(F.lds + 118784);
    LAS float* rsd  = (LAS float*)(F.lds + 127232);
    LAS int*   lcnt = (LAS int*)(F.lds + 127488);
    LAS int*   lbase= (LAS int*)(F.lds + 127616);
    LAS float* cstl = (LAS float*)(F.lds + 127744);
    const int tid = F.tid, lane = F.lane, w = F.wave;
    const float* mod = (const float*)(F.ws + WS_MOD);
    int* asg_e = (int*)(F.ws + WS_ASGE); int* asg_p = (int*)(F.ws + WS_ASGP); int* elist = (int*)(F.ws + WS_ELIST); float* egate = (float*)(F.ws + WS_EGATE);
    unsigned char* H = F.ws + WS_H;
    unsigned* gcnt = (unsigned*)(F.ctl + CW_ECNT);
    for (int unit = F.vcu; unit < T / 64; unit += F.G) {
        const int row0 = unit * 64, b = row0 / SEQ;
        const float* shf = mod + b * 6 * DM + 3 * DM; const float* scf = mod + b * 6 * DM + 4 * DM;
        const int srow = tid >> 3;
        if (tid < 32) lcnt[tid] = 0;
        float ssq = 0.f;
        const float* xsrc = F.out + (size_t)row0 * DM;
        const float* wsrc = (const float*)(F.ws + WS_WRP) + (size_t)b * DM * NE;
        const unsigned ring0 = (unsigned)__builtin_amdgcn_readfirstlane((int)(unsigned)(unsigned long)F.lds);
        const int xr0 = 8 * w + (lane >> 4), xr1 = xr0 + 4;
        const unsigned xv0 = (unsigned)(xr0 * DM * 4 + (((lane & 15) ^ (xr0 & 15)) << 4)), xv1 = (unsigned)(xr1 * DM * 4 + (((lane & 15) ^ (xr1 & 15)) << 4));
        const unsigned wv0 = (unsigned)((8 * w) * NE * 4 + lane * 16);
#define P5_ISSUE(c_) do { const unsigned st_ = ring0 + (unsigned)(((c_) & 3) * 24576); \
        glds16(xsrc + (c_) * 64, xv0, st_ + (unsigned)((8 * w) * 256)); glds16(xsrc + (c_) * 64, xv1, st_ + (unsigned)((8 * w + 4) * 256)); \
        glds16(wsrc + (size_t)(c_) * 64 * NE, wv0, st_ + 16384u + (unsigned)(w * 1024)); } while (0)
        P5_ISSUE(0); P5_ISSUE(1); P5_ISSUE(2);
        float acc[4][8];
#pragma unroll
        for (int i = 0; i < 4; ++i)
#pragma unroll
            for (int e = 0; e < 8; ++e) acc[i][e] = 0.f;
        const int rg = lane >> 2, eg = lane & 3;
#pragma unroll 1
        for (int c = 0; c < DM / 64; ++c) {
            if (c + 2 < DM / 64) asm volatile("s_waitcnt vmcnt(6)" ::: "memory"); else if (c + 1 < DM / 64) asm volatile("s_waitcnt vmcnt(3)" ::: "memory"); else asm volatile("s_waitcnt vmcnt(0)" ::: "memory");
            __syncthreads();
            if (c + 3 < DM / 64) P5_ISSUE(c + 3);
            const LAS char* Xs = (const LAS char*)F.lds + (c & 3) * 24576; const LAS float* Wb = (const LAS float*)(Xs + 16384) + (8 * w) * 32 + 8 * eg;
            { const f32x4 q0 = *(const LAS f32x4*)(Xs + srow * 256 + (tid & 7) * 32), q1 = *(const LAS f32x4*)(Xs + srow * 256 + (tid & 7) * 32 + 16);
              ssq += (q0.x * q0.x + q0.y * q0.y) + (q0.z * q0.z + q0.w * q0.w) + (q1.x * q1.x + q1.y * q1.y) + (q1.z * q1.z + q1.w * q1.w); }
#pragma unroll
            for (int kk = 0; kk < 8; kk += 4) {
                f32x4 a4[4];
#pragma unroll
                for (int i = 0; i < 4; ++i) a4[i] = *(const LAS f32x4*)(Xs + (rg + 16 * i) * 256 + (((2 * w + (kk >> 2)) ^ rg) << 4));
#pragma unroll
                for (int k = 0; k < 4; ++k) { const f32x4 w0 = *(const LAS f32x4*)(Wb + (kk + k) * 32), w1 = *(const LAS f32x4*)(Wb + (kk + k) * 32 + 4);
#pragma unroll
                    for (int i = 0; i < 4; ++i) { const float a = a4[i][k];
                        acc[i][0] += a * w0.x; acc[i][1] += a * w0.y; acc[i][2] += a * w0.z; acc[i][3] += a * w0.w;
                        acc[i][4] += a * w1.x; acc[i][5] += a * w1.y; acc[i][6] += a * w1.z; acc[i][7] += a * w1.w; } }
            }
        }
        __syncthreads();
#undef P5_ISSUE
#pragma unroll
        for (int i = 0; i < 4; ++i) { *(LAS f32x4*)(red + (w * 64 + rg + 16 * i) * 32 + 8 * eg) = (f32x4){acc[i][0], acc[i][1], acc[i][2], acc[i][3]};
            *(LAS f32x4*)(red + (w * 64 + rg + 16 * i) * 32 + 8 * eg + 4) = (f32x4){acc[i][4], acc[i][5], acc[i][6], acc[i][7]}; }
        if (tid < 32) cstl[tid] = ((const float*)(F.ws + WS_RCST))[b * 32 + tid];
        ssq += __shfl_xor(ssq, 1); ssq += __shfl_xor(ssq, 2); ssq += __shfl_xor(ssq, 4);
        const float rstd = 1.f / sqrtf(ssq * (1.f / DM) + EPS);
        if ((tid & 7) == 0) rsd[srow] = rstd;
        __syncthreads();
        { const int e0 = (tid & 7) * 4; f32x4 s = (f32x4){0.f, 0.f, 0.f, 0.f};
#pragma unroll
          for (int q = 0; q < 8; ++q) s += *(const LAS f32x4*)(red + (q * 64 + srow) * 32 + e0);
#pragma unroll
          for (int j = 0; j < 4; ++j) lg[srow * 33 + e0 + j] = s[j] * rstd + cstl[e0 + j]; }
        __syncthreads();
        int my_e[4], my_lp[4];
        if (tid < 64) { LAS float* lr = lg + tid * 33; float tv[4];
#pragma unroll
            for (int k = 0; k < 4; ++k) { float best = -3.0e38f; int bi = 0;
                for (int e = 0; e < 32; ++e) { const float v = lr[e]; if (v > best) { best = v; bi = e; } }
                tv[k] = best; my_e[k] = bi; lr[bi] = -3.4e38f; }
            const float e1 = expf(tv[1] - tv[0]), e2 = expf(tv[2] - tv[0]), e3 = expf(tv[3] - tv[0]), inv = 1.f / (1.f + e1 + e2 + e3);
            const int t = row0 + tid;
            lr[0] = inv; lr[1] = e1 * inv; lr[2] = e2 * inv; lr[3] = e3 * inv;
#pragma unroll
            for (int k = 0; k < 4; ++k) { asg_e[t * 4 + k] = my_e[k]; my_lp[k] = __hip_atomic_fetch_add(lcnt + my_e[k], 1, __ATOMIC_RELAXED, __HIP_MEMORY_SCOPE_WORKGROUP); } }
        __syncthreads();
        if (tid < 32) lbase[tid] = (int)atomicAdd(gcnt + tid * 16, (unsigned)lcnt[tid]);
        __syncthreads();
        if (tid < 64) { const int t = row0 + tid;
#pragma unroll
            for (int k = 0; k < 4; ++k) { const int pos = lbase[my_e[k]] + my_lp[k]; asg_p[t * 4 + k] = pos; elist[(size_t)my_e[k] * T + pos] = t; egate[(size_t)my_e[k] * T + pos] = lg[tid * 33 + k]; } }
        { f32x4 gm[8], sh[8];
#pragma unroll
          for (int j = 0; j < 8; ++j) { const int col = (lane + 64 * j) * 4; gm[j] = *(const f32x4*)(F.norm_ffn + col) * (*(const f32x4*)(scf + col) + 1.f); sh[j] = *(const f32x4*)(shf + col); }
          f32x4 xr_[2][8];
#pragma unroll
          for (int j = 0; j < 8; ++j) xr_[0][j] = ((const GAS f32x4*)(F.out + (size_t)(row0 + w * 8) * DM) + lane)[64 * j];
#pragma unroll
          for (int rr = 0; rr < 8; ++rr) { const int r = w * 8 + rr; const float rs = rsd[r];
            if (rr + 1 < 8) {
#pragma unroll
              for (int j = 0; j < 8; ++j) xr_[(rr + 1) & 1][j] = ((const GAS f32x4*)(F.out + (size_t)(row0 + r + 1) * DM) + lane)[64 * j]; }
            GAS unsigned* o4 = (GAS unsigned*)(H + (size_t)(row0 + r) * DM) + lane;
#pragma unroll
            for (int j = 0; j < 8; ++j) { const f32x4 y = xr_[rr & 1][j] * rs * gm[j] + sh[j]; o4[64 * j] = pg8::pk4_fp8(y.x, y.y, y.z, y.w); } } }
        __syncthreads();
    }
}

__device__ __forceinline__ void expert_starts(Frame& F, LAS int* pst  ) {
    if (F.tid == 0) { int s = 0; for (int e = 0; e < NE; ++e) { pst[e] = s; const int c = (int)__hip_atomic_load(F.ctl + CW_ECNT + e * 16, RLX_AGENT); s += (c + 255) & ~255; } pst[NE] = s; }
    __syncthreads();
}
template <int NPN, bool GATHER>
__device__ __forceinline__ int grouped_setup(Frame& F, LAS int* ul, LAS int* rt) {
    LAS int* pst = (LAS int*)(F.lds + XTR_OFF + 19456);
    expert_starts(F, pst);
    LAS int* nsh = pst + 34;
    if (F.tid == 0) *nsh = 0;
    __syncthreads();
    if (F.tid < 24) {
        long L = (long)F.tid * F.G + F.vcu; int e = 0, found = 0;
        for (e = 0; e < NE; ++e) { const int nte = (pst[e + 1] - pst[e]) >> 8; const long ne = (long)nte * NPN; if (L < ne) { found = 1; break; } L -= ne; }
        if (found) { const int nte = (pst[e + 1] - pst[e]) >> 8; const int pnl = (int)(L / nte), pml = (int)(L % nte);
            ul[5 * F.tid] = (pst[e] >> 8) + pml; ul[5 * F.tid + 1] = e * NPN + pnl; ul[5 * F.tid + 2] = e; ul[5 * F.tid + 3] = pml * 256;
            ul[5 * F.tid + 4] = (int)__hip_atomic_load(F.ctl + CW_ECNT + e * 16, RLX_AGENT); __hip_atomic_fetch_add(nsh, 1, __ATOMIC_RELAXED, __HIP_MEMORY_SCOPE_WORKGROUP); }
    }
    __syncthreads();
    const int n = *nsh;
    if (GATHER) { const int* elist = (const int*)(F.ws + WS_ELIST);
        for (int q = F.tid; q < n * 256; q += NTHR) { const int u5 = 5 * (q >> 8), lr = ul[u5 + 3] + (q & 255); rt[q] = lr < ul[u5 + 4] ? elist[(size_t)ul[u5 + 2] * T + lr] : 0; } }
    __syncthreads();
    return n;
}

__device__ __forceinline__ void p9_combine(Frame& F) {
    const int gw = F.vcu * NWAVES + F.wave, NGW = F.G * NWAVES, lane = F.lane;
    const float* mod = (const float*)(F.ws + WS_MOD); const unsigned char* Y = F.ws + WS_Y; const int* asg_e = (const int*)(F.ws + WS_ASGE); const int* asg_p = (const int*)(F.ws + WS_ASGP);
    LAS int* pst = (LAS int*)F.lds; expert_starts(F, pst);
    for (int blk = gw; blk < T / 8; blk += NGW) {
        const int row0 = blk * 8, b = row0 / SEQ;
        f32x4 gf[8];
#pragma unroll
        for (int j = 0; j < 8; ++j) gf[j] = *(const f32x4*)(mod + b * 6 * DM + 5 * DM + (lane + 64 * j) * 4) * (1.f / pg8::Y_SCALE);
        for (int rr = 0; rr < 8; ++rr) { const int t = row0 + rr;
            const int r0 = pst[asg_e[t * 4]] + asg_p[t * 4], r1 = pst[asg_e[t * 4 + 1]] + asg_p[t * 4 + 1], r2 = pst[asg_e[t * 4 + 2]] + asg_p[t * 4 + 2], r3 = pst[asg_e[t * 4 + 3]] + asg_p[t * 4 + 3];
            const GAS unsigned* y0 = (const GAS unsigned*)(Y + (size_t)r0 * DM) + lane; const GAS unsigned* y1 = (const GAS unsigned*)(Y + (size_t)r1 * DM) + lane;
            const GAS unsigned* y2 = (const GAS unsigned*)(Y + (size_t)r2 * DM) + lane; const GAS unsigned* y3 = (const GAS unsigned*)(Y + (size_t)r3 * DM) + lane;
            GAS f32x4* xo = (GAS f32x4*)(F.out + (size_t)t * DM) + lane;
#pragma unroll
            for (int j = 0; j < 8; ++j) { const unsigned a = y0[64 * j], bq = y1[64 * j], cq = y2[64 * j], d = y3[64 * j];
                const auto a0 = __builtin_amdgcn_cvt_pk_f32_fp8(a, false), a1 = __builtin_amdgcn_cvt_pk_f32_fp8(a, true), b0 = __builtin_amdgcn_cvt_pk_f32_fp8(bq, false), b1 = __builtin_amdgcn_cvt_pk_f32_fp8(bq, true);
                const auto c0 = __builtin_amdgcn_cvt_pk_f32_fp8(cq, false), c1 = __builtin_amdgcn_cvt_pk_f32_fp8(cq, true), d0 = __builtin_amdgcn_cvt_pk_f32_fp8(d, false), d1 = __builtin_amdgcn_cvt_pk_f32_fp8(d, true);
                f32x4 s; s.x = (a0[0] + b0[0]) + (c0[0] + d0[0]); s.y = (a0[1] + b0[1]) + (c0[1] + d0[1]); s.z = (a1[0] + b1[0]) + (c1[0] + d1[0]); s.w = (a1[1] + b1[1]) + (c1[1] + d1[1]);
                xo[64 * j] = xo[64 * j] + gf[j] * s; } }
    }
}

constexpr int N_PHASES = 11;
struct Args { const float* in[24]; float* out; unsigned char* ws; int ph_lo, ph_hi; };
__global__ void __launch_bounds__(NTHR, 2) fwd_kernel(Args args) {
    extern __shared__ __attribute__((aligned(16))) unsigned char lds[];
    Frame F;
    F.lds = (LAS unsigned char*)lds;
    F.MISC = (volatile LAS unsigned*)(F.lds + MISC_OFF);
    F.tid = threadIdx.x; F.lane = F.tid & 63; F.wave = __builtin_amdgcn_readfirstlane(F.tid >> 6);
    F.G = gridDim.x; { const int bx = blockIdx.x; F.vcu = (F.G % 8 == 0) ? (bx % 8) * (F.G / 8) + bx / 8 : bx; }
    F.ws = args.ws; F.ctl = (gu32*)(args.ws + WS_CTL); F.out = args.out;
    F.x = args.in[0]; F.c = args.in[1]; F.relb = args.in[2]; F.w_ada = args.in[3]; F.b_ada = args.in[4]; F.norm_attn = args.in[5]; F.norm_ffn = args.in[6];
    F.w_in = args.in[7]; F.w_out = args.in[8]; F.a_q_norm = args.in[9]; F.a_k_norm = args.in[10]; F.b_q_norm = args.in[11]; F.b_k_norm = args.in[12];
    F.lq1 = args.in[13]; F.lk1 = args.in[14]; F.lq2 = args.in[15]; F.lk2 = args.in[16]; F.b_subln = args.in[17]; F.w_router = args.in[18]; F.b_router = args.in[19];
    F.w_gu = args.in[20]; F.b_gu = args.in[21]; F.w_down = args.in[22]; F.b_down = args.in[23];
    if (F.tid < 64) ((LAS unsigned*)(F.lds + MISC_OFF))[F.tid] = 0u;
    __syncthreads();
    const int lo = args.ph_lo, hi = args.ph_hi;
    const bool multi = (hi - lo) > 1;
    XcdBarrier bar; bar.bar = (unsigned*)(F.ctl + CW_BAR); bar.x = 0; bar.st = nullptr;
    if (multi) bar = xcd_barrier_post((unsigned*)(F.ctl + CW_BAR), F.MISC + 8);
#ifndef PH_MASK
#define PH_MASK 0x7ff
#endif
#define IN(k) (((PH_MASK >> (k)) & 1) && lo <= (k) && (k) < hi)
#define SEAM(k) do { if (IN(k) && IN((k) + 1)) xcd_barrier(bar); F.tid = opaque_tid(); F.lane = F.tid & 63; } while (0)
#ifndef PROBE_DUP
#define PROBE_DUP 0
#endif
#define REP(k) _Pragma("nounroll") for (int rep_ = 0; rep_ < 1 + ((PROBE_DUP >> (k)) & 1); ++rep_)

    if (IN(0)) REP(0) { p0_mod_tables(F);
        if (F.G == 256) {
            constexpr int SPLIT = 192 * NWAVES * 2; static_assert(P0_ITEMS_A - SPLIT == 64 * NWAVES * 7, "item split");
            if (F.vcu < 192) p0_weights_strided(F, F.vcu * NWAVES + F.wave, SPLIT, 192 * NWAVES);
            else p0_weights_strided(F, SPLIT + (F.vcu - 192) * NWAVES + F.wave, P0_ITEMS_A, 64 * NWAVES);
        } else p0_weights(F, 0, P0_ITEMS_A); }
    SEAM(0);
    if (IN(1)) REP(1) { p1_h1(F); }
    SEAM(1);
    if (IN(2)) REP(2) {
        pg8::Gemm g{F.ws + WS_H, F.ws + WS_WIN, DM}; pg8::StaticOrder S; S.init(T, INW, DM, F.G, (int)blockIdx.x);
        pg8::EpiProj E{(bf16*)(F.ws + WS_PROJ), INW, 1.f / 32.f};
        pg8::gemm_phase<pg8::EpiProj, pg8::StaticOrder, true, true>(F.lds, g, S, E);
    }
    SEAM(2);
    if (IN(3)) p2b_knorm(F);
    SEAM(3);
    if (IN(4)) REP(4) p3_attention(F);
    SEAM(4);
    if (IN(5)) REP(5) {
        pg8::Gemm g{F.ws + WS_AO, F.ws + WS_WOUT, DM}; pg8::StaticOrder S; S.init(T, DM, DM, F.G, (int)blockIdx.x);
        pg8::EpiResid E{F.x, F.out, (const float*)(F.ws + WS_MOD) + 2 * DM, 1.f / (pg8::WQ_SCALE * attn::AO_SCALE)};
        pg8::gemm_phase<pg8::EpiResid, pg8::StaticOrder, true, true>(F.lds, g, S, E);
    }
    SEAM(5);
    if (IN(6)) p5_router(F);
    SEAM(6);
    if (IN(8)) REP(8) {
        LAS int* rt = (LAS int*)(F.lds + XTR_OFF); LAS int* ul = (LAS int*)(F.lds + XTR_OFF + 18432);
        const int n = grouped_setup<16, true>(F, ul, rt);
        pg8::Gemm g{F.ws + WS_H, F.ws + WS_WGU, DM}; pg8::GroupedOrder<true> S{ul, n, rt, DM};
        pg8::EpiSwiglu E{F.ws + WS_ACT, F.b_gu};
        pg8::gemm_phase<pg8::EpiSwiglu, pg8::GroupedOrder<true>, true, true>(F.lds, g, S, E);
    }
    SEAM(8);
    if (IN(9)) REP(9) {
        LAS int* rt = (LAS int*)(F.lds + XTR_OFF); LAS int* ul = (LAS int*)(F.lds + XTR_OFF + 18432);
        const int n = grouped_setup<8, false>(F, ul, rt);
        pg8::Gemm g{F.ws + WS_ACT, F.ws + WS_WDN, FF}; pg8::GroupedOrder<false> S{ul, n, rt, FF};
        pg8::EpiDown E{F.ws + WS_Y, F.b_down, (const float*)(F.ws + WS_EGATE)};
        pg8::gemm_phase<pg8::EpiDown, pg8::GroupedOrder<false>, true, true>(F.lds, g, S, E);
    }
    SEAM(9);
    if (IN(10)) p9_combine(F);
#undef IN
#undef SEAM
}

extern "C" void kernel_launch(void* const* d_in, const int* in_sizes, int n_in, void* d_out, int out_size, void* d_ws, size_t ws_size, hipStream_t stream) {
    static int grid = 0;
    if (grid == 0) {
        if (n_in != 24 || in_sizes[0] != T * DM || out_size != T * DM || ws_size < WS_END) {
            fprintf(stderr, "kernel_launch: shape mismatch: n_in %d in0 %d out %d ws %zu (need %zu)\n", n_in, n_in > 0 ? in_sizes[0] : -1, out_size, ws_size, (size_t)WS_END); grid = -1; return; }
        int dev = 0, cus = 0, per_cu = 0;
        if (hipGetDevice(&dev) != hipSuccess || hipDeviceGetAttribute(&cus, hipDeviceAttributeMultiprocessorCount, dev) != hipSuccess) { fprintf(stderr, "kernel_launch: device query failed\n"); grid = -1; return; }
        if (hipFuncSetAttribute((const void*)fwd_kernel, hipFuncAttributeMaxDynamicSharedMemorySize, LDS_BYTES) != hipSuccess) { fprintf(stderr, "kernel_launch: hipFuncSetAttribute failed\n"); grid = -1; return; }
        if (hipOccupancyMaxActiveBlocksPerMultiprocessor(&per_cu, (const void*)fwd_kernel, NTHR, LDS_BYTES) != hipSuccess || per_cu < 1)
            fprintf(stderr, "kernel_launch: note: occupancy query reports %d workgroups per CU\n", per_cu);
        (void)hipGetLastError();
        grid = cus;
        if (grid != 256) { fprintf(stderr, "kernel_launch: built for a 256-CU device, found %d CUs\n", cus); grid = -1; return; }
    }
    if (grid < 0) return;
    if (hipMemsetAsync((char*)d_ws + WS_CTL, 0, CTL_ZERO, stream) != hipSuccess) { fprintf(stderr, "kernel_launch: memset failed\n"); return; }
    Args a{};
    for (int i = 0; i < 24; ++i) a.in[i] = (const float*)d_in[i];
    a.out = (float*)d_out; a.ws = (unsigned char*)d_ws;
#if MK_ONE_LAUNCH
    a.ph_lo = 0; a.ph_hi = N_PHASES;
    hipLaunchKernelGGL(fwd_kernel, dim3(grid), dim3(NTHR), LDS_BYTES, stream, a);
#else
    for (int p = 0; p < N_PHASES; ++p) { a.ph_lo = p; a.ph_hi = p + 1; hipLaunchKernelGGL(fwd_kernel, dim3(grid), dim3(NTHR), LDS_BYTES, stream, a); }
#endif
    const hipError_t le = hipPeekAtLastError();
    if (le != hipSuccess) fprintf(stderr, "kernel_launch: launch failed: %s\n", hipGetErrorName(le));
}
```

```cpp
#include <hip/hip_runtime.h>
#include <cstdio>
#include <cstdint>

#ifndef MK_ONE_LAUNCH
#define MK_ONE_LAUNCH 1
#endif

constexpr int NB = 4, SEQ = 4096, DM = 2048, T = NB * SEQ;
constexpr int INW = 4608, NE = 32, TOPK = 4, FF = 2048;
constexpr int COL_QA = 0, COL_KA = 1024, COL_VA = 1280, COL_QB = 1536, COL_KB = 2560, COL_VB = 3584;
constexpr int NASG = T * TOPK;
constexpr int MAXROWS = NASG + NE * 256;
constexpr float EPS = 1e-6f;
constexpr int NWAVES = 8, NTHR = 512;

constexpr size_t al256(size_t x) { return (x + 255) & ~(size_t)255; }
constexpr size_t WS_CTL = 0, CTL_BYTES = 1u << 20;
constexpr size_t WS_MOD  = WS_CTL + CTL_BYTES;
constexpr size_t WS_ROPE = WS_MOD + al256((size_t)NB * 6 * DM * 4);
constexpr size_t WS_BIAS = WS_ROPE + al256(2 * 64 * 32 * 4);
constexpr size_t WS_MISC = WS_BIAS + al256(8 * 512 * 4);
constexpr size_t WS_WIN  = WS_MISC + 256;
constexpr size_t WS_WOUT = WS_WIN + (size_t)INW * DM * 2;
constexpr size_t WS_WGU  = WS_WOUT + (size_t)DM * DM * 2;
constexpr size_t WS_WDN  = WS_WGU + (size_t)NE * 2 * FF * DM;
constexpr size_t WS_H    = WS_WDN + (size_t)NE * DM * FF;
constexpr size_t WS_PROJ = WS_H + (size_t)T * DM * 2;
constexpr size_t WS_AO   = WS_PROJ + (size_t)T * INW * 2;
constexpr size_t WS_STASH= WS_AO + (size_t)T * DM * 2;
constexpr size_t WS_ASGE = WS_STASH + (size_t)256 * 64 * 512 * 4;
constexpr size_t WS_ASGP = WS_ASGE + (size_t)NASG * 4;
constexpr size_t WS_ASGG = WS_ASGP + (size_t)NASG * 4;
constexpr size_t WS_ELIST = WS_ASGG + (size_t)NASG * 4;
constexpr size_t WS_EGATE = WS_ELIST + (size_t)NE * T * 4;
constexpr size_t WS_ACT  = WS_EGATE + (size_t)NE * T * 4;
constexpr size_t WS_Y    = WS_ACT + (size_t)MAXROWS * FF;
constexpr size_t WS_VT   = WS_Y + (size_t)MAXROWS * DM * 2;
constexpr size_t WS_KA8  = WS_VT + (size_t)NB * 10 * 64 * 8192;
constexpr size_t WS_KB8  = WS_KA8 + (size_t)NB * 2 * 64 * 8192;
constexpr size_t WS_WRP  = WS_KB8 + (size_t)NB * 16 * 64 * 4096;
constexpr size_t WS_RCST = WS_WRP + (size_t)NB * DM * NE * 4;
constexpr size_t WS_END  = WS_RCST + 512;
constexpr int CW_BAR = 4096;
constexpr int CW_ECNT = 8192;
constexpr size_t CTL_ZERO = 40960;
static_assert((CW_ECNT + NE * 16) * 4 <= (int)CTL_ZERO && (CW_BAR + 3456) * 4 <= (int)CTL_ZERO, "control words inside the per-call memset");

constexpr int RING_BYTES = 131072;
constexpr int XTR_OFF = RING_BYTES, XTR_BYTES = 20480;
constexpr int MISC_OFF = XTR_OFF + XTR_BYTES;
constexpr int EPI_OFF = MISC_OFF + 256, EPI_BYTES = 4096;
constexpr int LDS_BYTES = EPI_OFF + EPI_BYTES;
static_assert(LDS_BYTES <= 163840, "LDS");

#define GAS __attribute__((address_space(1)))
#define LAS __attribute__((address_space(3)))
typedef unsigned short bf16;
typedef unsigned u32x4 __attribute__((ext_vector_type(4)));
typedef unsigned u32x2 __attribute__((ext_vector_type(2)));
typedef float f32x4 __attribute__((ext_vector_type(4)));
typedef float f32x2 __attribute__((ext_vector_type(2)));
typedef float f32x16 __attribute__((ext_vector_type(16)));
typedef short bf16x8 __attribute__((ext_vector_type(8)));
typedef short s16x4 __attribute__((ext_vector_type(4)));
typedef GAS unsigned gu32;
#define RLX_AGENT __ATOMIC_RELAXED, __HIP_MEMORY_SCOPE_AGENT
#define LDS_WAIT() asm volatile("s_waitcnt lgkmcnt(0)" ::: "memory")
#define VM_WAIT() asm volatile("s_waitcnt vmcnt(0)" ::: "memory")
#define SBAR() __builtin_amdgcn_sched_barrier(0)

__device__ __forceinline__ unsigned cvtpk(float lo, float hi) { unsigned r; asm volatile("v_cvt_pk_bf16_f32 %0, %1, %2" : "=v"(r) : "v"(lo), "v"(hi)); return r; }
template <class T> __device__ __forceinline__ T* opaque_sptr(T* p) { asm volatile("" : "+s"(p)); return p; }
__device__ __forceinline__ int opaque_tid() { int t = threadIdx.x; asm volatile("" : "+v"(t)); return t; }
__device__ __forceinline__ float bf2f(unsigned short h) { return __builtin_bit_cast(float, (unsigned)h << 16); }
__device__ __forceinline__ float bflo(unsigned w) { return __builtin_bit_cast(float, w << 16); }
__device__ __forceinline__ float bfhi(unsigned w) { return __builtin_bit_cast(float, w & 0xffff0000u); }

#define XB_TMO      128
#define XB_XCNT(j)  (256  + 64 * (j))
#define XB_XSUB(j)  (1280 + 64 * (j))
#define XB_XGEN(j)  (2304 + 64 * (j))
#define XB_TOP      3328
#define XB_TOPGEN   3392
#define XCD_BAR_WORDS 3456
#define XB_SPIN_CAP (1u << 22)
__device__ __forceinline__ unsigned xb_ld(unsigned* p)              { return __hip_atomic_load(p, __ATOMIC_RELAXED, __HIP_MEMORY_SCOPE_AGENT); }
__device__ __forceinline__ unsigned xb_add(unsigned* p, unsigned v) { return __hip_atomic_fetch_add(p, v, __ATOMIC_RELAXED, __HIP_MEMORY_SCOPE_AGENT); }
__device__ __forceinline__ unsigned xb_xcc_id() { return (unsigned)__builtin_amdgcn_s_getreg((3 << 11) | 20) & 0xFu; }
#define XB_SPIN(cond, bar) do { unsigned _sp = 0; while (cond) { __builtin_amdgcn_s_sleep(1); \
    if ((++_sp & 255u) == 0u) { if (xb_ld(&(bar)[XB_TMO])) break; if (_sp > XB_SPIN_CAP) { atomicAdd(&(bar)[XB_TMO], 1u); break; } } } } while (0)
struct XcdBarrier { unsigned* bar; unsigned x; volatile LAS unsigned* st; };
__device__ __forceinline__ XcdBarrier xcd_barrier_post(unsigned* bar, volatile LAS unsigned* st) {
    XcdBarrier b; b.bar = bar; b.x = xb_xcc_id(); b.st = st;
    if (threadIdx.x == 0) (void)xb_add(&bar[XB_XCNT(b.x)], 1u);
    return b;
}
__device__ __forceinline__ void xcd_barrier_complete(unsigned* bar, unsigned x, unsigned& nloc, unsigned& nx) {
    const unsigned G = gridDim.x * gridDim.y * gridDim.z;
    unsigned sum, cnt, mine, sp = 0u;
    for (;;) {
        sum = 0u; cnt = 0u; mine = 0u;
#pragma unroll
        for (unsigned j = 0; j < 16; ++j) { const unsigned c = xb_ld(&bar[XB_XCNT(j)]); sum += c; cnt += (c > 0u) ? 1u : 0u; mine = (j == x) ? c : mine; }
        if (sum == G) break;
        __builtin_amdgcn_s_sleep(1);
        if ((++sp & 255u) == 0u) { if (xb_ld(&bar[XB_TMO])) break; if (sp > XB_SPIN_CAP) { atomicAdd(&bar[XB_TMO], 1u); break; } }
    }
    nloc = mine > 0u ? mine : 1u; nx = cnt > 0u ? cnt : 1u;
}
__device__ __forceinline__ void xcd_barrier(const XcdBarrier& b) {
    asm volatile("s_waitcnt vmcnt(0)" ::: "memory");
    __syncthreads();
    if (threadIdx.x == 0) {
        unsigned* bar = b.bar;
        __builtin_amdgcn_s_waitcnt(0);
        unsigned nloc = b.st[0], nx = b.st[1];
        if (nloc == 0u) { xcd_barrier_complete(bar, b.x, nloc, nx); b.st[0] = nloc; b.st[1] = nx; }
        const unsigned old = xb_add(&bar[XB_XSUB(b.x)], 1u);
        const unsigned gen = old / nloc;
        if (old + 1u == (gen + 1u) * nloc) {
            __builtin_amdgcn_fence(__ATOMIC_RELEASE, "agent");
            asm volatile("s_waitcnt vmcnt(0)" ::: "memory");
            const unsigned og = xb_add(&bar[XB_TOP], 1u);
            const unsigned tg = og / nx;
            if (og + 1u == (tg + 1u) * nx) xb_add(&bar[XB_TOPGEN], 1u);
            else XB_SPIN(xb_ld(&bar[XB_TOPGEN]) == tg, bar);
            __builtin_amdgcn_fence(__ATOMIC_ACQUIRE, "agent");
            xb_add(&bar[XB_XGEN(b.x)], 1u);
            asm volatile("s_waitcnt vmcnt(0)" ::: "memory");
        } else {
            XB_SPIN(xb_ld(&bar[XB_XGEN(b.x)]) == gen, bar);
            __builtin_amdgcn_fence(__ATOMIC_ACQUIRE, "agent");
            asm volatile("s_waitcnt vmcnt(0)" ::: "memory");
        }
    }
    __syncthreads();
}

namespace pg8 {
constexpr int BM = 256, BK = 64, HALF = 128, HTB = HALF * BK * 2, NXCD = 8, WGM = 8;
__host__ __device__ __forceinline__ int lds_byte(int r, int c) { const int st = (r >> 4) * 2 + (c >> 5), rr = r & 15, cc = c & 31, ob = rr * 64 + cc * 2; return st * 1024 + (ob ^ (((ob >> 9) & 1) << 5)); }
__host__ __device__ __forceinline__ void stage_rc(int b, int& R, int& C) { const int st = b / 1024, sb = b % 1024, swz = sb ^ (((sb >> 9) & 1) << 5); R = (st >> 1) * 16 + swz / 64; C = (st & 1) * 32 + (swz % 64) / 2; }
__host__ __device__ __forceinline__ int perm32(int rho) { const int n = rho >> 4, i = rho & 15; return 8 * (i >> 2) + 4 * n + (i & 3); }

struct Unit { int pm, pn, e, lr0, cnt; };
struct Gemm { const void* A; const void* Bt; int rowb; };

struct StaticOrder {
    int nM, nN, nwg, G, c, rowb;
    __device__ void init(int M, int N, int rowb_, int G_, int c_) { nM = M / BM; nN = N / BM; nwg = nM * nN; G = G_; c = c_; rowb = rowb_; }
    __device__ __forceinline__ bool next(int i, Unit& u) const {
        const long L = (long)i * G + c; if (L >= nwg) return false;
        int wgid = (int)L; { const int q = nwg / NXCD, r = nwg % NXCD, xcd = wgid % NXCD, off = wgid / NXCD; wgid = (xcd < r ? xcd * (q + 1) : r * (q + 1) + (xcd - r) * q) + off; }
        const int nig = WGM * nN, gid = wgid / nig, fm = gid * WGM, gsz = (nM - fm) < WGM ? (nM - fm) : WGM;
        u.pm = fm + ((wgid % nig) % gsz); u.pn = (wgid % nig) / gsz; u.e = 0; u.lr0 = 0; u.cnt = 0; return true;
    }
    __device__ __forceinline__ unsigned aoff(int, const Unit& u, int h, int R, int Cb) const { return (unsigned)((u.pm * BM + h * HALF + R) * rowb + Cb); }
};
template <bool GATHER> struct GroupedOrder {
    const LAS int* ul; int n; const LAS int* rt; int rowb;
    __device__ __forceinline__ bool next(int i, Unit& u) const {
        if (i >= n) return false;
        u.pm = __builtin_amdgcn_readfirstlane(ul[5 * i]); u.pn = __builtin_amdgcn_readfirstlane(ul[5 * i + 1]); u.e = __builtin_amdgcn_readfirstlane(ul[5 * i + 2]);
        u.lr0 = __builtin_amdgcn_readfirstlane(ul[5 * i + 3]); u.cnt = __builtin_amdgcn_readfirstlane(ul[5 * i + 4]); return true;
    }
    __device__ __forceinline__ unsigned aoff(int i, const Unit& u, int h, int R, int Cb) const {
        if (GATHER) return (unsigned)(rt[i * 256 + h * HALF + R] * rowb + Cb);
        return (unsigned)((u.pm * BM + h * HALF + R) * rowb + Cb);
    }
};

struct EpiProj {
    static constexpr bool PERM = true, PREF = false;
    bf16* O; int ldc; float sc;
    __device__ __forceinline__ void operator()(const f32x4 (&acc)[2][2][4][2], const Unit& u, int wr, int wc, int fr, int fq) const {
        const int row0 = u.pm * BM + wr * 64 + fr, col0 = u.pn * BM + wc * 32 + 8 * fq;
#pragma unroll
        for (int ai = 0; ai < 2; ++ai)
#pragma unroll
            for (int m = 0; m < 4; ++m) { bf16* rowp = O + (size_t)(row0 + ai * HALF + m * 16) * ldc + col0;
#pragma unroll
                for (int bj = 0; bj < 2; ++bj) { const f32x4 v0 = acc[ai][bj][m][0] * sc, v1 = acc[ai][bj][m][1] * sc;
                    u32x4 w; w.x = cvtpk(v0[0], v0[1]); w.y = cvtpk(v0[2], v0[3]); w.z = cvtpk(v1[0], v1[1]); w.w = cvtpk(v1[2], v1[3]);
                    *(u32x4*)(rowp + bj * HALF) = w; } }
    }
};
struct EpiResid {
    static constexpr bool PERM = false, PREF = false;
    const float* x; float* out; const float* ga; float sc;
    __device__ __forceinline__ void operator()(const f32x4 (&acc)[2][2][4][2], const Unit& u, int wr, int wc, int fr, int fq) const {
        const int row0 = u.pm * BM + wr * 64 + fr, col0 = u.pn * BM + wc * 32 + 4 * fq;
        const float* gab = ga + (size_t)((u.pm * BM) / SEQ) * 6 * DM;
        f32x4 gv[2][2];
#pragma unroll
        for (int bj = 0; bj < 2; ++bj)
#pragma unroll
            for (int n = 0; n < 2; ++n) gv[bj][n] = *(const f32x4*)(gab + col0 + bj * HALF + n * 16) * sc;
#pragma unroll
        for (int ai = 0; ai < 2; ++ai)
#pragma unroll
            for (int m = 0; m < 4; ++m) { const size_t ro = (size_t)(row0 + ai * HALF + m * 16) * DM + col0;
#pragma unroll
                for (int bj = 0; bj < 2; ++bj)
#pragma unroll
                    for (int n = 0; n < 2; ++n) { const f32x4 xv = *(const f32x4*)(x + ro + bj * HALF + n * 16);
                        *(f32x4*)(out + ro + bj * HALF + n * 16) = xv + gv[bj][n] * acc[ai][bj][m][n]; } }
    }
};
constexpr float WQ_SCALE = 32.f, ACT_SCALE = 4.f;
__device__ __forceinline__ unsigned pk4_fp8_x32(float a, float b, float c, float d) {
    unsigned r = 0; const float sc = 1.f / 32.f;
    asm("v_cvt_scalef32_pk_fp8_f32 %0, %1, %2, %3" : "+v"(r) : "v"(a), "v"(b), "v"(sc));
    asm("v_cvt_scalef32_pk_fp8_f32 %0, %1, %2, %3 op_sel:[0,0,0,1]" : "+v"(r) : "v"(c), "v"(d), "v"(sc));
    return r; }
__device__ __forceinline__ unsigned pk4_fp8_u(float a, float b, float c, float d) {
    unsigned old; asm volatile("" : "=v"(old)); unsigned p = __builtin_amdgcn_cvt_pk_fp8_f32(a, b, old, false); return __builtin_amdgcn_cvt_pk_fp8_f32(c, d, p, true); }
__device__ __forceinline__ unsigned pk4_fp8(float a, float b, float c, float d) {
    unsigned p = __builtin_amdgcn_cvt_pk_fp8_f32(a, b, 0, false); return __builtin_amdgcn_cvt_pk_fp8_f32(c, d, p, true); }
struct EpiSwiglu {
    static constexpr bool PERM = true, PREF = true;
    unsigned char* act; const float* bgu;
    __device__ __forceinline__ void prefetch(LAS unsigned char* ebuf, const Unit& u, int wid, int lane) const {
        if (wid == 0) { const int pnl = u.pn - u.e * 16; const float* src = bgu + (size_t)u.e * 2 * FF + pnl * 128 + (lane < 32 ? lane * 4 : FF + (lane - 32) * 4);
            __builtin_amdgcn_global_load_lds((const unsigned*)src, (LAS unsigned*)ebuf, 16, 0, 0); }
    }
    __device__ __forceinline__ void operator()(const f32x4 (&acc)[2][2][4][2], const Unit& u, int wr, int wc, int fr, int fq, const LAS unsigned char* ebuf) const {
        const int pnl = u.pn - u.e * 16, row0 = u.pm * BM + wr * 64 + fr, col0 = pnl * 128 + wc * 32 + 8 * fq;
        const LAS float* bl = (const LAS float*)ebuf + wc * 32 + 8 * fq;
        f32x4 bgv[2], buv[2];
#pragma unroll
        for (int n = 0; n < 2; ++n) { bgv[n] = *(const LAS f32x4*)(bl + 4 * n); buv[n] = *(const LAS f32x4*)(bl + 128 + 4 * n); }
#pragma unroll
        for (int ai = 0; ai < 2; ++ai)
#pragma unroll
            for (int m = 0; m < 4; ++m) { float o[8];
#pragma unroll
                for (int n = 0; n < 2; ++n)
#pragma unroll
                    for (int j = 0; j < 4; ++j) { float gg = acc[ai][0][m][n][j] * (1.f / WQ_SCALE) + bgv[n][j], uu = acc[ai][1][m][n][j] * (1.f / WQ_SCALE) + buv[n][j];
                        gg = fminf(gg, 7.f); uu = __builtin_amdgcn_fmed3f(uu, -7.f, 7.f);
                        const float glu = gg * __builtin_amdgcn_rcpf(1.f + __builtin_amdgcn_exp2f(gg * (-1.702f * 1.4426950408889634f)));
                        o[n * 4 + j] = fmaf(uu, ACT_SCALE, ACT_SCALE) * glu; }
                u32x2 w; w.x = pk4_fp8(o[0], o[1], o[2], o[3]); w.y = pk4_fp8(o[4], o[5], o[6], o[7]);
                *(u32x2*)(act + (size_t)(row0 + ai * HALF + m * 16) * FF + col0) = w; }
    }
};
constexpr float Y_SCALE = 16.f;
struct EpiDown {
    static constexpr bool PERM = true, PREF = true;
    unsigned char* y; const float* bdn; const float* egate;
    __device__ __forceinline__ void prefetch(LAS unsigned char* ebuf, const Unit& u, int wid, int lane) const {
        if (wid == 0) __builtin_amdgcn_global_load_lds((const unsigned*)(egate + (size_t)u.e * T + u.lr0 + lane * 4), (LAS unsigned*)ebuf, 16, 0, 0);
        if (wid == 1) { const int pnl = u.pn - u.e * 8; __builtin_amdgcn_global_load_lds((const unsigned*)(bdn + (size_t)u.e * DM + pnl * BM + lane * 4), (LAS unsigned*)(ebuf + 1024), 16, 0, 0); }
    }
    __device__ __forceinline__ void operator()(const f32x4 (&acc)[2][2][4][2], const Unit& u, int wr, int wc, int fr, int fq, const LAS unsigned char* ebuf) const {
        const int pnl = u.pn - u.e * 8, rl0 = wr * 64 + fr, row0 = u.pm * BM + rl0, col0 = pnl * BM + wc * 32 + 8 * fq;
        const LAS float* gl = (const LAS float*)ebuf; const LAS float* bl = (const LAS float*)(ebuf + 1024) + wc * 32 + 8 * fq;
        f32x4 bv[2][2];
#pragma unroll
        for (int bj = 0; bj < 2; ++bj)
#pragma unroll
            for (int n = 0; n < 2; ++n) bv[bj][n] = *(const LAS f32x4*)(bl + bj * HALF + 4 * n);
#pragma unroll
        for (int ai = 0; ai < 2; ++ai)
#pragma unroll
            for (int m = 0; m < 4; ++m) { const int rl = rl0 + ai * HALF + m * 16, row = u.pm * BM + rl; const float gt = (u.lr0 + rl) < u.cnt ? gl[rl] * Y_SCALE : 0.f; unsigned char* rowp = y + (size_t)row * DM + col0;
#pragma unroll
                for (int bj = 0; bj < 2; ++bj) { const f32x4 v0 = (acc[ai][bj][m][0] * (1.f / (WQ_SCALE * ACT_SCALE)) + bv[bj][0]) * gt, v1 = (acc[ai][bj][m][1] * (1.f / (WQ_SCALE * ACT_SCALE)) + bv[bj][1]) * gt;
                    u32x2 w; w.x = pk4_fp8(v0[0], v0[1], v0[2], v0[3]); w.y = pk4_fp8(v1[0], v1[1], v1[2], v1[3]);
                    *(u32x2*)(rowp + bj * HALF) = w; } }
    }
};

typedef int v8i __attribute__((ext_vector_type(8)));
template <class Epi, class Sched, bool ALIGN_EPI, bool F8>
__device__ __forceinline__ void gemm_phase(LAS unsigned char* lds, const Gemm g, const Sched& S, const Epi& E) {
    const int tid = opaque_tid(), wid = __builtin_amdgcn_readfirstlane(tid >> 6), lane = tid & 63, wr = wid >> 2, wc = wid & 3, fr = lane & 15, fq = lane >> 4;
    const int rowb = g.rowb, nt = rowb / 128;
    int Rs[2], Cs[2]; unsigned voffB[2];
#pragma unroll
    for (int i = 0; i < 2; ++i) { int R, C; stage_rc(tid * 16 + i * 8192, R, C); Rs[i] = R; Cs[i] = C * 2; const int Rb = Epi::PERM ? ((R & ~31) + perm32(R & 31)) : R; voffB[i] = (unsigned)(Rb * rowb + C * 2); }
    const size_t kstep = (size_t)128;
    const size_t hstep = (size_t)HALF * rowb;
    const size_t tstep = 2 * hstep;
    const unsigned ldsw = (unsigned)wid * 1024u;
    const int aoffl = lds_byte(wr * 64 + fr, fq * 8), boffl = lds_byte(wc * 32 + fr, fq * 8);
#define PG8_SA(b, h) (((b) * 2 + (h)) * HTB)
#define PG8_SB(b, h) ((4 + (b) * 2 + (h)) * HTB)
#define PG8_STAGE(bufoff, gbase, voff) do { _Pragma("unroll") for (int _i = 0; _i < 2; ++_i) \
        __builtin_amdgcn_global_load_lds((const unsigned*)((const char*)(gbase) + (voff)[_i]), (LAS unsigned*)(lds + (bufoff) + ldsw + _i * 8192), 16, 0, 0); } while (0)
#define PG8_LDA(dst, b, h) do { _Pragma("unroll") for (int m = 0; m < 4; ++m) _Pragma("unroll") for (int k = 0; k < 2; ++k) dst[m][k] = *(const LAS bf16x8*)(lds + PG8_SA(b, h) + aoffl + m * 2048 + k * 1024); } while (0)
#define PG8_LDB(dst, b, h) do { _Pragma("unroll") for (int n = 0; n < 2; ++n) _Pragma("unroll") for (int k = 0; k < 2; ++k) dst[n][k] = *(const LAS bf16x8*)(lds + PG8_SB(b, h) + boffl + n * 2048 + k * 1024); } while (0)
#define PG8_CAT(x) __builtin_bit_cast(v8i, __builtin_shufflevector(x[0], x[1], 0, 1, 2, 3, 4, 5, 6, 7, 8, 9, 10, 11, 12, 13, 14, 15))
#define PG8_MMA(ai, bj, At, Bt) do { __builtin_amdgcn_s_setprio(1); _Pragma("unroll") for (int m = 0; m < 4; ++m) _Pragma("unroll") for (int n = 0; n < 2; ++n) { \
        if constexpr (F8) { const v8i _b = PG8_CAT(Bt[n]), _a = PG8_CAT(At[m]); asm volatile("s_nop 1\n\tv_mfma_f32_16x16x128_f8f6f4 %0, %1, %2, %0" : "+v"(acc[ai][bj][m][n]) : "v"(_b), "v"(_a)); } \
        else { _Pragma("unroll") for (int k = 0; k < 2; ++k) acc[ai][bj][m][n] = __builtin_amdgcn_mfma_f32_16x16x32_bf16(Bt[n][k], At[m][k], acc[ai][bj][m][n], 0, 0, 0); } } \
        __builtin_amdgcn_s_setprio(0); } while (0)
#define PG8_WAIT_V(n) asm volatile("s_waitcnt vmcnt(" #n ")" ::: "memory")
#define PG8_WAIT_L(n) asm volatile("s_waitcnt lgkmcnt(" #n ")" ::: "memory")
#define PG8_BAR __builtin_amdgcn_s_barrier()
#define PG8_SCHED __builtin_amdgcn_sched_barrier(0)
    Unit cur, nxt; int ui = 0;
    if (!S.next(0, cur)) return;
    f32x4 acc[2][2][4][2];
#pragma unroll
    for (int a = 0; a < 2; ++a)
#pragma unroll
        for (int b = 0; b < 2; ++b)
#pragma unroll
            for (int m = 0; m < 4; ++m)
#pragma unroll
                for (int n = 0; n < 2; ++n) acc[a][b][m][n] = (f32x4){0.f, 0.f, 0.f, 0.f};
    bf16x8 At[4][2], B0[2][2], B1[2][2];
    unsigned aoc[2][2], aon[2][2];
#pragma unroll
    for (int h = 0; h < 2; ++h)
#pragma unroll
        for (int i = 0; i < 2; ++i) aoc[h][i] = S.aoff(0, cur, h, Rs[i], Cs[i]);
    const char* Ab = (const char*)g.A;
    const char* cB = (const char*)g.Bt + (size_t)cur.pn * tstep;
    PG8_STAGE(PG8_SB(0, 0), cB, voffB); PG8_STAGE(PG8_SB(0, 1), cB + hstep, voffB); PG8_STAGE(PG8_SA(0, 0), Ab, aoc[0]); PG8_STAGE(PG8_SA(0, 1), Ab, aoc[1]);
    if (wr == 1) PG8_BAR;
    PG8_WAIT_V(2); PG8_BAR;
    PG8_STAGE(PG8_SB(1, 0), cB + kstep, voffB); PG8_STAGE(PG8_SA(1, 0), Ab + kstep, aoc[0]); PG8_STAGE(PG8_SB(1, 1), cB + hstep + kstep, voffB);
    PG8_WAIT_V(6); PG8_BAR;
    for (;;) {
        if constexpr (Epi::PREF) E.prefetch(lds + EPI_OFF + (ui & 1) * 2048, cur, wid, lane);
        const bool has_next = S.next(ui + 1, nxt);
#pragma unroll
        for (int h = 0; h < 2; ++h)
#pragma unroll
            for (int i = 0; i < 2; ++i) aon[h][i] = has_next ? S.aoff(ui + 1, nxt, h, Rs[i], Cs[i]) : aoc[h][i];
        const char* nB = has_next ? (const char*)g.Bt + (size_t)nxt.pn * tstep : cB;
        for (int t = 0; t < nt; t += 2) {
            const bool last = (t == nt - 2);
            const char* a1 = Ab + (size_t)(t + 1) * kstep;
            const char* a2 = last ? Ab : Ab + (size_t)(t + 2) * kstep; const char* b2 = last ? nB : cB + (size_t)(t + 2) * kstep;
            const char* a3 = a2 + kstep; const char* b3 = b2 + kstep;
            unsigned a2o[2][2];
#pragma unroll
            for (int h = 0; h < 2; ++h)
#pragma unroll
                for (int i = 0; i < 2; ++i) a2o[h][i] = last ? aon[h][i] : aoc[h][i];
            PG8_LDB(B0, 0, 0); PG8_LDB(B1, 0, 1); PG8_SCHED; PG8_LDA(At, 0, 0); PG8_STAGE(PG8_SA(1, 1), a1, aoc[1]);
            PG8_WAIT_V(8); PG8_WAIT_L(0); PG8_BAR; PG8_MMA(0, 0, At, B0); PG8_MMA(0, 1, At, B1); PG8_BAR; PG8_SCHED;
            PG8_LDA(At, 0, 1); PG8_STAGE(PG8_SB(0, 0), b2, voffB); PG8_STAGE(PG8_SB(0, 1), b2 + hstep, voffB); PG8_STAGE(PG8_SA(0, 0), a2, a2o[0]);
            PG8_WAIT_V(8); PG8_WAIT_L(0); PG8_BAR; PG8_MMA(1, 0, At, B0); PG8_MMA(1, 1, At, B1); PG8_BAR; PG8_SCHED;
            PG8_LDB(B0, 1, 0); PG8_LDB(B1, 1, 1); PG8_SCHED; PG8_LDA(At, 1, 0); PG8_STAGE(PG8_SA(0, 1), a2, a2o[1]);
            PG8_WAIT_V(8); PG8_WAIT_L(0); PG8_BAR; PG8_MMA(0, 0, At, B0); PG8_MMA(0, 1, At, B1); PG8_BAR; PG8_SCHED;
            PG8_LDA(At, 1, 1); PG8_STAGE(PG8_SB(1, 0), b3, voffB); PG8_STAGE(PG8_SB(1, 1), b3 + hstep, voffB); PG8_STAGE(PG8_SA(1, 0), a3, a2o[0]);
            PG8_WAIT_V(8); PG8_WAIT_L(0); PG8_BAR; PG8_MMA(1, 0, At, B0); PG8_MMA(1, 1, At, B1); PG8_BAR; PG8_SCHED;
        }
        if constexpr (ALIGN_EPI) { if (wr == 0) PG8_BAR; }
        if constexpr (F8) asm volatile("s_nop 7\n\ts_nop 7\n\ts_nop 7" ::: "memory");
        if constexpr (Epi::PREF) E(acc, cur, wr, wc, fr, fq, lds + EPI_OFF + (ui & 1) * 2048); else E(acc, cur, wr, wc, fr, fq);
        if (!has_next) break;
#pragma unroll
        for (int a = 0; a < 2; ++a)
#pragma unroll
            for (int b = 0; b < 2; ++b)
#pragma unroll
                for (int m = 0; m < 4; ++m)
#pragma unroll
                    for (int n = 0; n < 2; ++n) acc[a][b][m][n] = (f32x4){0.f, 0.f, 0.f, 0.f};
        cur = nxt; cB = nB; ++ui;
#pragma unroll
        for (int h = 0; h < 2; ++h)
#pragma unroll
            for (int i = 0; i < 2; ++i) aoc[h][i] = aon[h][i];
        if constexpr (ALIGN_EPI) { if (wr == 1) PG8_BAR; }
    }
    PG8_WAIT_V(0);
    if constexpr (!ALIGN_EPI) { if (wr == 0) PG8_BAR; }
    PG8_BAR;
#undef PG8_SA
#undef PG8_SB
#undef PG8_STAGE
#undef PG8_LDA
#undef PG8_LDB
#undef PG8_MMA
#undef PG8_CAT
#undef PG8_WAIT_V
#undef PG8_WAIT_L
#undef PG8_BAR
#undef PG8_SCHED
}
}

struct Frame {
    LAS unsigned char* lds;
    volatile LAS unsigned* MISC;
    gu32* ctl;
    unsigned char* ws;
    int tid, lane, wave, vcu, G;
    const float *x, *c, *relb, *w_ada, *b_ada, *norm_attn, *norm_ffn, *w_in, *w_out, *a_q_norm, *a_k_norm, *b_q_norm, *b_k_norm,
                *lq1, *lk1, *lq2, *lk2, *b_subln, *w_router, *b_router, *w_gu, *b_gu, *w_down, *b_down;
    float* out;
};
__device__ __forceinline__ float wave_sum(float v) {
#pragma unroll
    for (int o = 1; o < 64; o <<= 1) v += __shfl_xor(v, o);
    return v;
}
__device__ __forceinline__ unsigned f2bf(float f) { unsigned u = __builtin_bit_cast(unsigned, f); return (u + 0x7fffu + ((u >> 16) & 1u)) >> 16; }
__device__ __forceinline__ unsigned pk2(float lo, float hi) { return f2bf(lo) | (f2bf(hi) << 16); }

constexpr int P0_ITEMS_A = (DM / 64) * (INW / 32) + (DM / 64) * (DM / 32);
constexpr int P0_ITEMS_ALL = P0_ITEMS_A + NE * ((DM / 64) * (2 * FF / 32) + (FF / 64) * (DM / 32));
struct WItem { const float* src; unsigned char* dst; int N, pitch, f8; };
__device__ __forceinline__ void witem_decode(Frame& F, int it, WItem& d) {
    constexpr int I_IN = (DM / 64) * (INW / 32), I_OUT = (DM / 64) * (DM / 32), I_GU1 = (DM / 64) * (2 * FF / 32), I_DN1 = (FF / 64) * (DM / 32);
    constexpr int I_GU = NE * I_GU1;
    int r = it;
    if (r < I_IN) { const int nblk = INW / 32, kb = r / nblk, nb = r % nblk; d.src = F.w_in + (size_t)(64 * kb) * INW + 32 * nb; d.N = INW; d.pitch = DM; d.f8 = 1;
        d.dst = F.ws + WS_WIN + (size_t)(32 * nb) * DM + 64 * kb; return; } r -= I_IN;
    if (r < I_OUT) { const int nblk = DM / 32, kb = r / nblk, nb = r % nblk; d.src = F.w_out + (size_t)(64 * kb) * DM + 32 * nb; d.N = DM; d.pitch = DM; d.f8 = 1;
        d.dst = F.ws + WS_WOUT + (size_t)(32 * nb) * DM + 64 * kb; return; } r -= I_OUT;
    if (r < I_GU) { const int e = r / I_GU1, q = r % I_GU1, nblk = 2 * FF / 32, kb = q / nblk, nb = q % nblk, n0 = 32 * nb;
        const int half = n0 / FF, nn = n0 % FF, orow = (nn / 128) * 256 + half * 128 + (nn % 128);
        d.src = F.w_gu + (size_t)e * DM * 2 * FF + (size_t)(64 * kb) * (2 * FF) + n0; d.N = 2 * FF; d.pitch = DM; d.f8 = 1;
        d.dst = F.ws + WS_WGU + (size_t)e * 2 * FF * DM + (size_t)orow * DM + 64 * kb; return; } r -= I_GU;
    { const int e = r / I_DN1, q = r % I_DN1, nblk = DM / 32, kb = q / nblk, nb = q % nblk;
        d.src = F.w_down + (size_t)e * FF * DM + (size_t)(64 * kb) * DM + 32 * nb; d.N = DM; d.pitch = FF; d.f8 = 1;
        d.dst = F.ws + WS_WDN + (size_t)e * DM * FF + (size_t)(32 * nb) * FF + 64 * kb; }
}

#define WC_PARAMS int& wc_it, int& wc_cur, int& wc_q
#define WC_ARGS wc_it, wc_cur, wc_q
constexpr int WC_END = P0_ITEMS_ALL;
__device__ __forceinline__ void moe_item(Frame& F, int it, const float*& src, int& N, unsigned char*& dst) {
    constexpr int I_GU = NE * (DM / 64) * (2 * FF / 32);
    const unsigned r = (unsigned)(it - P0_ITEMS_A);
    if (r < (unsigned)I_GU) { const unsigned e = r >> 12, q = r & 4095u, kb = q >> 7, n0 = (q & 127u) << 5, half = n0 >> 11, nn = n0 & 2047u, orow = ((nn >> 7) << 8) + (half << 7) + (nn & 127u);
        src = F.w_gu + ((size_t)e << 23) + ((size_t)kb << 18) + n0; N = 2 * FF; dst = F.ws + WS_WGU + ((size_t)e << 23) + ((size_t)orow << 11) + (kb << 6); }
    else { const unsigned r2 = r - I_GU, e = r2 >> 11, q = r2 & 2047u, kb = q >> 6, n0 = (q & 63u) << 5;
        src = F.w_down + ((size_t)e << 22) + ((size_t)kb << 17) + n0; N = DM; dst = F.ws + WS_WDN + ((size_t)e << 22) + ((size_t)n0 << 11) + (kb << 6); }
}
__device__ __forceinline__ void glds16_nt(const void* sbase, unsigned voff, unsigned lds_dst) { unsigned keep;
    asm volatile("s_mov_b32 %0, m0\n\ts_mov_b32 m0, %2\n\ts_nop 0\n\tglobal_load_lds_dwordx4 %1, %3 nt\n\ts_mov_b32 m0, %0" : "=&s"(keep) : "v"(voff), "s"(lds_dst), "s"(sbase) : "memory"); }
__device__ __forceinline__ void glds16(const void* sbase, unsigned voff, unsigned lds_dst) { unsigned keep;
    asm volatile("s_mov_b32 %0, m0\n\ts_mov_b32 m0, %2\n\ts_nop 0\n\tglobal_load_lds_dwordx4 %1, %3\n\ts_mov_b32 m0, %0" : "=&s"(keep) : "v"(voff), "s"(lds_dst), "s"(sbase) : "memory"); }
__device__ __forceinline__ void wconv_issue(Frame& F, WC_PARAMS, LAS char* buf, int lane, const int half = 2) {
    const int it = (half == 1) ? wc_cur : wc_it;
    if (it >= 0 && it < WC_END) { const float* src; int N; unsigned char* dst; moe_item(F, it, src, N, dst);
        const unsigned r = lane >> 3, cc = lane & 7; const unsigned lb = (unsigned)__builtin_amdgcn_readfirstlane((int)(unsigned)(unsigned long)buf);
        const unsigned vrow = r * (unsigned)N * 4u;
#pragma unroll
        for (int i = 0; i < 8; ++i) if (half == 2 || (i >> 2) == half) glds16_nt(src + (size_t)(8 * i) * N, vrow + ((cc ^ (unsigned)i) << 4), lb + i * 1024);
        if (half != 1) { wc_cur = wc_it; wc_it += F.G * NWAVES; }
    } else if (half != 1) wc_cur = -1;
}
__device__ __forceinline__ void wconv_step(Frame& F, WC_PARAMS, LAS char* buf, int lane, bool last) {
    if (wc_q & 16) { wc_q &= 15; wconv_issue(F, WC_ARGS, buf, lane, 1); }
    if (++wc_q == 4) { wc_q = 0;
        if (wc_cur >= 0) { const float* src; int N; unsigned char* dst; moe_item(F, wc_cur, src, N, dst);
            const int c8 = lane & 7;
            typedef float f32x2_ __attribute__((ext_vector_type(2)));
            static_assert(pg8::WQ_SCALE == 32.f, "scale folded into the conversion");
#define WC_ADDR(qd_) ((unsigned)(unsigned long)buf + 4u * (unsigned)((8 * c8) * 32 + 4 * (((8 * (qd_) + (lane >> 3)) >> 2) ^ c8) + ((8 * (qd_) + (lane >> 3)) & 3)))
#define WC_READ(R0, R1, R2, R3, qd_) asm volatile("ds_read2_b32 %0, %4 offset1:32\n\tds_read2_b32 %1, %4 offset0:64 offset1:96\n\tds_read2_b32 %2, %4 offset0:128 offset1:160\n\tds_read2_b32 %3, %4 offset0:192 offset1:224" \
                : "=&v"(R0), "=&v"(R1), "=&v"(R2), "=&v"(R3) : "v"(WC_ADDR(qd_)) : "memory")
#define WC_WAIT(n_, R0, R1, R2, R3) asm volatile("s_waitcnt lgkmcnt(" #n_ ")" : "+v"(R0), "+v"(R1), "+v"(R2), "+v"(R3) :: "memory")
#define WC_PUT(R0, R1, R2, R3, qd_) do { u32x2 o_; o_.x = pg8::pk4_fp8_x32(R0.x, R0.y, R1.x, R1.y); o_.y = pg8::pk4_fp8_x32(R2.x, R2.y, R3.x, R3.y); \
                __builtin_nontemporal_store(o_, (GAS u32x2*)(dst + ((size_t)(8 * (qd_) + (lane >> 3)) << 11) + 8 * c8)); } while (0)
            { f32x2_ a0, a1, a2, a3, b0, b1, b2, b3;
              asm volatile("s_waitcnt lgkmcnt(0)" ::: "memory");
              WC_READ(a0, a1, a2, a3, 0); WC_READ(b0, b1, b2, b3, 1);
              WC_WAIT(4, a0, a1, a2, a3); WC_PUT(a0, a1, a2, a3, 0); WC_READ(a0, a1, a2, a3, 2);
              WC_WAIT(4, b0, b1, b2, b3); WC_PUT(b0, b1, b2, b3, 1); WC_READ(b0, b1, b2, b3, 3);
              WC_WAIT(4, a0, a1, a2, a3); WC_PUT(a0, a1, a2, a3, 2);
              WC_WAIT(0, b0, b1, b2, b3); WC_PUT(b0, b1, b2, b3, 3); }
#undef WC_ADDR
#undef WC_READ
#undef WC_WAIT
#undef WC_PUT
            wc_cur = -1; }
        if (!last) { LDS_WAIT(); wconv_issue(F, WC_ARGS, buf, lane, 0); if (wc_cur >= 0) wc_q |= 16; }
    }
}

namespace attn {
constexpr int KVBLK = 64, QBLK = 32;
constexpr float THR = 2.f;
constexpr float PSH = 4.f;
constexpr int LDR = INW;
constexpr int SHM_V = 128 * KVBLK, SHM_K = KVBLK * 128 * 2;
constexpr int OFF_V = 0, OFF_K = 3 * 8192, OFF_WS = OFF_K + 3 * 8192, OFF_BT = OFF_WS + NWAVES * 64 * 4, OFF_OST = OFF_BT + 512 * 4, ATTN_LDS = OFF_OST + NWAVES * 8192;
static_assert(ATTN_LDS <= MISC_OFF, "attention LDS");
#define KSWZ128(row, colB) ((row) * 256 + ((colB) ^ (((row) & 7) << 4)))
#define KSWZ64(row, colB)  ((row) * 128 + ((colB) ^ ((((row) >> 1) & 7) << 4)))
__device__ __forceinline__ int crow(int r, int hi) { return (r & 3) + 8 * (r >> 2) + 4 * hi; }

__device__ __forceinline__ void partialSM(f32x16& p0, f32x16& p1, float& m_reg, float& mn, float& alpha, const float C, const float thr_raw, const float braw) {
  float pmax = p0[0];
#pragma unroll
  for (int r = 1; r < 16; ++r) pmax = fmaxf(pmax, p0[r]);
#pragma unroll
  for (int r = 0; r < 16; ++r) pmax = fmaxf(pmax, p1[r]);
  { auto rr = __builtin_amdgcn_permlane32_swap(__float_as_uint(pmax), __float_as_uint(pmax), false, false);
    pmax = fmaxf(__uint_as_float(rr[0]), __uint_as_float(rr[1])); }
  pmax += braw;
  if (__builtin_expect(__all(pmax - m_reg <= thr_raw), 1)) { mn = m_reg; alpha = 1.f; }
  else { mn = fmaxf(m_reg, pmax); alpha = __builtin_amdgcn_exp2f((m_reg - mn) * C); m_reg = mn; }
  const float mnC = (braw - mn) * C + PSH;
#pragma unroll
  for (int r = 0; r < 16; ++r) p0[r] = fmaf(p0[r], C, mnC);
#pragma unroll
  for (int r = 0; r < 16; ++r) p1[r] = fmaf(p1[r], C, mnC);
#pragma unroll
  for (int r = 0; r < 16; ++r) p0[r] = __builtin_amdgcn_exp2f(p0[r]);
}
__device__ __forceinline__ void finishSM(f32x16& p0, f32x16& p1, pg8::v8i& pa) {
#pragma unroll
  for (int r = 0; r < 16; ++r) p1[r] = __builtin_amdgcn_exp2f(p1[r]);
  pa[0] = (int)pg8::pk4_fp8_u(p0[0], p0[1], p0[2], p0[3]);   pa[1] = (int)pg8::pk4_fp8_u(p0[4], p0[5], p0[6], p0[7]);
  pa[2] = (int)pg8::pk4_fp8_u(p0[8], p0[9], p0[10], p0[11]); pa[3] = (int)pg8::pk4_fp8_u(p0[12], p0[13], p0[14], p0[15]);
  pa[4] = (int)pg8::pk4_fp8_u(p1[0], p1[1], p1[2], p1[3]);   pa[5] = (int)pg8::pk4_fp8_u(p1[4], p1[5], p1[6], p1[7]);
  pa[6] = (int)pg8::pk4_fp8_u(p1[8], p1[9], p1[10], p1[11]); pa[7] = (int)pg8::pk4_fp8_u(p1[12], p1[13], p1[14], p1[15]);
}
template <int ND0> __device__ __forceinline__ void qkt(f32x16& p0, f32x16& p1, const LAS char* Ks, const bf16x8 (&qr)[ND0], int r32, int hi) {
  p0 = f32x16{}; p1 = f32x16{};
#pragma unroll
  for (int d0 = 0; d0 < ND0; ++d0) { const int cb = (d0 * 16 + hi * 8) * 2;
    bf16x8 b0, b1;
    if (ND0 == 8) { b0 = *(const LAS bf16x8*)(Ks + KSWZ128(r32, cb)); b1 = *(const LAS bf16x8*)(Ks + KSWZ128(32 + r32, cb)); }
    else          { b0 = *(const LAS bf16x8*)(Ks + KSWZ64(r32, cb));  b1 = *(const LAS bf16x8*)(Ks + KSWZ64(32 + r32, cb)); }
    p0 = __builtin_amdgcn_mfma_f32_32x32x16_bf16(b0, qr[d0], p0, 0, 0, 0);
    p1 = __builtin_amdgcn_mfma_f32_32x32x16_bf16(b1, qr[d0], p1, 0, 0, 0); }
}
struct QF8 { pg8::v8i f[2]; };
__device__ __forceinline__ void qkt8(f32x16& p0, f32x16& p1, const LAS char* Ks, const QF8& q, int r32, int hi) {
  const int sw = (r32 >> 1) & 7, rb = r32 * 128;
  const int o00 = rb + (((2 * hi) ^ sw) << 4), o01 = rb + (((2 * hi + 1) ^ sw) << 4), o10 = rb + (((4 + 2 * hi) ^ sw) << 4), o11 = rb + (((5 + 2 * hi) ^ sw) << 4);
  const u32x4 a0 = *(const LAS u32x4*)(Ks + o00), a1 = *(const LAS u32x4*)(Ks + o01), a2 = *(const LAS u32x4*)(Ks + o10), a3 = *(const LAS u32x4*)(Ks + o11);
  const u32x4 b0 = *(const LAS u32x4*)(Ks + 4096 + o00), b1 = *(const LAS u32x4*)(Ks + 4096 + o01), b2 = *(const LAS u32x4*)(Ks + 4096 + o10), b3 = *(const LAS u32x4*)(Ks + 4096 + o11);
  asm volatile("s_waitcnt lgkmcnt(0)" ::: "memory"); SBAR();
#define V8(LO_, HI_) (pg8::v8i){(int)LO_[0], (int)LO_[1], (int)LO_[2], (int)LO_[3], (int)HI_[0], (int)HI_[1], (int)HI_[2], (int)HI_[3]}
  { const pg8::v8i k0 = V8(a0, a1), k1 = V8(a2, a3);
    asm volatile("s_nop 1\n\tv_mfma_f32_32x32x64_f8f6f4 %0, %1, %2, 0\n\tv_mfma_f32_32x32x64_f8f6f4 %0, %3, %4, %0" : "=&v"(p0) : "v"(k0), "v"(q.f[0]), "v"(k1), "v"(q.f[1])); }
  { const pg8::v8i k0 = V8(b0, b1), k1 = V8(b2, b3);
    asm volatile("s_nop 1\n\tv_mfma_f32_32x32x64_f8f6f4 %0, %1, %2, 0\n\tv_mfma_f32_32x32x64_f8f6f4 %0, %3, %4, %0" : "=&v"(p1) : "v"(k0), "v"(q.f[0]), "v"(k1), "v"(q.f[1])); }
#undef V8
  asm volatile("s_nop 7\n\ts_nop 7\n\ts_nop 3" ::: "memory");
}
typedef int v4i_f4 __attribute__((ext_vector_type(4)));
#define PVL(LACC, PA, ONES) asm volatile("s_nop 1\n\tv_mfma_f32_32x32x64_f8f6f4 %0, %1, %2, %0 cbsz:0 blgp:4" : "+v"(LACC) : "v"(PA), "v"(ONES))
__device__ __forceinline__ void pv_d0(f32x16 (&o)[4], const LAS char* Vs, int off0, int off1, const pg8::v8i& pa, f32x16& lacc, const v4i_f4& ones) {
  u32x4 lo[4], hi4[4];
#pragma unroll
  for (int d0 = 0; d0 < 4; ++d0) { lo[d0] = *(const LAS u32x4*)(Vs + d0 * 2048 + off0); hi4[d0] = *(const LAS u32x4*)(Vs + d0 * 2048 + off1); }
  asm volatile("s_waitcnt lgkmcnt(0)" ::: "memory"); SBAR();
#pragma unroll
  for (int d0 = 0; d0 < 4; ++d0) { const pg8::v8i vf = {(int)lo[d0].x, (int)lo[d0].y, (int)lo[d0].z, (int)lo[d0].w, (int)hi4[d0].x, (int)hi4[d0].y, (int)hi4[d0].z, (int)hi4[d0].w};
    asm volatile("s_nop 1\n\tv_mfma_f32_32x32x64_f8f6f4 %0, %1, %2, %0" : "+v"(o[d0]) : "v"(pa), "v"(vf)); }
  PVL(lacc, pa, ones);
}
#define PIN(x) asm volatile("" : "+v"(x))
__device__ __forceinline__ float max3f(float a, float b, float c) { float r; asm("v_max3_f32 %0, %1, %2, %3" : "=v"(r) : "v"(a), "v"(b), "v"(c)); return r; }
__device__ __forceinline__ float max2f(float a, float b) { float r; asm("v_max_f32 %0, %1, %2" : "=v"(r) : "v"(a), "v"(b)); return r; }
__device__ __forceinline__ float max16(const f32x16& p) {
  float m = max3f(p[0], p[1], p[2]);
#pragma unroll
  for (int r = 3; r < 15; r += 2) m = max3f(m, p[r], p[r + 1]);
  return max2f(m, p[15]);
}
struct VF { u32x4 lo[4], hi4[4]; };
__device__ __forceinline__ void vf_load(VF& f, const LAS char* Vs, int off0, int off1) {
#pragma unroll
  for (int d0 = 0; d0 < 4; ++d0) { f.lo[d0] = *(const LAS u32x4*)(Vs + d0 * 2048 + off0); f.hi4[d0] = *(const LAS u32x4*)(Vs + d0 * 2048 + off1); }
}
template <bool PRE  >
__device__ __forceinline__ void pv_psm(f32x16 (&o)[4], const LAS char* Vs, int off0, int off1, const pg8::v8i& pa, VF& vfr,
                                       f32x16& p0, f32x16& p1, float& m_reg, float& mn, float& alpha, const float C, const float thr_raw, const float braw, f32x16& lacc, const v4i_f4& ones) {
  if (!PRE) vf_load(vfr, Vs, off0, off1);
  u32x4 (&lo)[4] = vfr.lo; u32x4 (&hi4)[4] = vfr.hi4;
  SBAR();
#define PV1(d0) do { const pg8::v8i vf = {(int)lo[d0].x, (int)lo[d0].y, (int)lo[d0].z, (int)lo[d0].w, (int)hi4[d0].x, (int)hi4[d0].y, (int)hi4[d0].z, (int)hi4[d0].w}; \
    asm volatile("s_nop 1\n\tv_mfma_f32_32x32x64_f8f6f4 %0, %1, %2, %0" : "+v"(o[d0]) : "v"(pa), "v"(vf)); SBAR(); } while (0)
  PV1(0);
  float mx0 = max16(p0); PIN(mx0); SBAR();
  PV1(1);
  float pmax = max2f(mx0, max16(p1));
  { auto rr = __builtin_amdgcn_permlane32_swap(__float_as_uint(pmax), __float_as_uint(pmax), false, false);
    pmax = max2f(__uint_as_float(rr[0]), __uint_as_float(rr[1])); }
  pmax += braw;
  alpha = 1.f;
  if (__builtin_expect(!__all(pmax - m_reg <= thr_raw), 0)) {
    asm volatile("" ::: "memory");
    const float mnew = max2f(m_reg, pmax); alpha = __builtin_amdgcn_exp2f((m_reg - mnew) * C); m_reg = mnew; }
  mn = m_reg;
  float mnC = (braw - m_reg) * C + PSH; PIN(mnC);
  SBAR();
  PV1(2);
#pragma unroll
  for (int r = 0; r < 16; ++r) p0[r] = fmaf(p0[r], C, mnC);
#pragma unroll
  for (int r = 0; r < 16; ++r) p1[r] = fmaf(p1[r], C, mnC);
  PIN(p0); PIN(p1); SBAR();
  PV1(3);
#pragma unroll
  for (int r = 0; r < 8; ++r) p0[r] = __builtin_amdgcn_exp2f(p0[r]);
  PIN(p0); SBAR();
  PVL(lacc, pa, ones); SBAR();
#pragma unroll
  for (int r = 8; r < 16; ++r) p0[r] = __builtin_amdgcn_exp2f(p0[r]);
  PIN(p0); SBAR();
#undef PV1
}
__device__ __forceinline__ void qkt8_fsm(f32x16& n0, f32x16& n1, const LAS char* Ks, const QF8& q, int r32, int hi,
                                         f32x16& p0, f32x16& p1, pg8::v8i& pa, VF& vfr, const LAS char* Vs, int voff0, int voff1) {
  const int sw = (r32 >> 1) & 7, rb = r32 * 128;
  const int o00 = rb + (((2 * hi) ^ sw) << 4), o01 = rb + (((2 * hi + 1) ^ sw) << 4), o10 = rb + (((4 + 2 * hi) ^ sw) << 4), o11 = rb + (((5 + 2 * hi) ^ sw) << 4);
  const u32x4 a0 = *(const LAS u32x4*)(Ks + o00), a1 = *(const LAS u32x4*)(Ks + o01), a2 = *(const LAS u32x4*)(Ks + o10), a3 = *(const LAS u32x4*)(Ks + o11);
  asm volatile("" ::: "memory"); SBAR();
#define V8(LO_, HI_) (pg8::v8i){(int)LO_[0], (int)LO_[1], (int)LO_[2], (int)LO_[3], (int)HI_[0], (int)HI_[1], (int)HI_[2], (int)HI_[3]}
  { const pg8::v8i k0 = V8(a0, a1); asm volatile("s_nop 1\n\tv_mfma_f32_32x32x64_f8f6f4 %0, %1, %2, 0" : "=&v"(n0) : "v"(k0), "v"(q.f[0])); } SBAR();
  const u32x4 b0 = *(const LAS u32x4*)(Ks + 4096 + o00), b1 = *(const LAS u32x4*)(Ks + 4096 + o01), b2 = *(const LAS u32x4*)(Ks + 4096 + o10), b3 = *(const LAS u32x4*)(Ks + 4096 + o11);
  asm volatile("" ::: "memory"); SBAR();
#pragma unroll
  for (int r = 0; r < 8; ++r) p1[r] = __builtin_amdgcn_exp2f(p1[r]);
  PIN(p1); SBAR();
  { const pg8::v8i k1 = V8(a2, a3); asm volatile("s_nop 1\n\tv_mfma_f32_32x32x64_f8f6f4 %0, %1, %2, %0" : "+v"(n0) : "v"(k1), "v"(q.f[1])); } SBAR();
#pragma unroll
  for (int r = 8; r < 16; ++r) p1[r] = __builtin_amdgcn_exp2f(p1[r]);
  PIN(p1); SBAR();
  { const pg8::v8i k0 = V8(b0, b1); asm volatile("s_nop 1\n\tv_mfma_f32_32x32x64_f8f6f4 %0, %1, %2, 0" : "=&v"(n1) : "v"(k0), "v"(q.f[0])); } SBAR();
  pa[0] = (int)pg8::pk4_fp8_u(p0[0], p0[1], p0[2], p0[3]);   pa[1] = (int)pg8::pk4_fp8_u(p0[4], p0[5], p0[6], p0[7]);
  pa[2] = (int)pg8::pk4_fp8_u(p0[8], p0[9], p0[10], p0[11]); pa[3] = (int)pg8::pk4_fp8_u(p0[12], p0[13], p0[14], p0[15]);
  PIN(pa); SBAR();
  { const pg8::v8i k1 = V8(b2, b3); asm volatile("s_nop 1\n\tv_mfma_f32_32x32x64_f8f6f4 %0, %1, %2, %0" : "+v"(n1) : "v"(k1), "v"(q.f[1])); } SBAR();
#undef V8
  pa[4] = (int)pg8::pk4_fp8_u(p1[0], p1[1], p1[2], p1[3]);   pa[5] = (int)pg8::pk4_fp8_u(p1[4], p1[5], p1[6], p1[7]);
  pa[6] = (int)pg8::pk4_fp8_u(p1[8], p1[9], p1[10], p1[11]); pa[7] = (int)pg8::pk4_fp8_u(p1[12], p1[13], p1[14], p1[15]);
  PIN(pa);
  asm volatile("s_nop 7\n\ts_nop 7" ::: "memory");
}
__device__ __forceinline__ void qkt4_fsm(f32x16& n0, f32x16& n1, const LAS char* Ks, const bf16x8 (&qr)[4], int r32, int hi,
                                         f32x16& p0, f32x16& p1, pg8::v8i& pa) {
  bf16x8 b0[4], b1[4];
#pragma unroll
  for (int d0 = 0; d0 < 2; ++d0) { const int cb = (d0 * 16 + hi * 8) * 2;
    b0[d0] = *(const LAS bf16x8*)(Ks + KSWZ64(r32, cb)); b1[d0] = *(const LAS bf16x8*)(Ks + KSWZ64(32 + r32, cb)); }
  asm volatile("" ::: "memory"); SBAR();
#define MM0(ACC, A_, B_) do { asm volatile("s_nop 1\n\tv_mfma_f32_32x32x16_bf16 %0, %1, %2, 0" : "=&v"(ACC) : "v"(A_), "v"(B_)); SBAR(); } while (0)
#define MM(ACC, A_, B_)  do { asm volatile("s_nop 1\n\tv_mfma_f32_32x32x16_bf16 %0, %1, %2, %0" : "+v"(ACC) : "v"(A_), "v"(B_)); SBAR(); } while (0)
#define EXP4(i0) do { _Pragma("unroll") for (int r = (i0); r < (i0) + 4; ++r) p1[r] = __builtin_amdgcn_exp2f(p1[r]); PIN(p1); SBAR(); } while (0)
  EXP4(0);
  MM0(n0, b0[0], qr[0]); EXP4(4);
  MM0(n1, b1[0], qr[0]);
#pragma unroll
  for (int d0 = 2; d0 < 4; ++d0) { const int cb = (d0 * 16 + hi * 8) * 2;
    b0[d0] = *(const LAS bf16x8*)(Ks + KSWZ64(r32, cb)); b1[d0] = *(const LAS bf16x8*)(Ks + KSWZ64(32 + r32, cb)); }
  asm volatile("" ::: "memory"); SBAR();
  EXP4(8);
  MM(n0, b0[1], qr[1]);  EXP4(12);
  MM(n1, b1[1], qr[1]);
  pa[0] = (int)pg8::pk4_fp8_u(p0[0], p0[1], p0[2], p0[3]);   pa[1] = (int)pg8::pk4_fp8_u(p0[4], p0[5], p0[6], p0[7]);   PIN(pa); SBAR();
  MM(n0, b0[2], qr[2]);
  pa[2] = (int)pg8::pk4_fp8_u(p0[8], p0[9], p0[10], p0[11]); pa[3] = (int)pg8::pk4_fp8_u(p0[12], p0[13], p0[14], p0[15]); PIN(pa); SBAR();
  MM(n1, b1[2], qr[2]);
  pa[4] = (int)pg8::pk4_fp8_u(p1[0], p1[1], p1[2], p1[3]);   pa[5] = (int)pg8::pk4_fp8_u(p1[4], p1[5], p1[6], p1[7]);   PIN(pa); SBAR();
  MM(n0, b0[3], qr[3]);
  pa[6] = (int)pg8::pk4_fp8_u(p1[8], p1[9], p1[10], p1[11]); pa[7] = (int)pg8::pk4_fp8_u(p1[12], p1[13], p1[14], p1[15]); PIN(pa); SBAR();
  MM(n1, b1[3], qr[3]);
  asm volatile("s_nop 7\n\ts_nop 7" ::: "memory");
#undef MM0
#undef MM
#undef EXP4
}
struct QB8 { pg8::v8i f; };
#define KB8_READ(a0, a1, b0, b1) const int sw_ = (r32 >> 2) & 3, rb_ = r32 * 64, o0_ = rb_ + (((2 * hi) ^ sw_) << 4), o1_ = rb_ + (((2 * hi + 1) ^ sw_) << 4); \
  const u32x4 a0 = *(const LAS u32x4*)(Ks + o0_), a1 = *(const LAS u32x4*)(Ks + o1_), b0 = *(const LAS u32x4*)(Ks + 2048 + o0_), b1 = *(const LAS u32x4*)(Ks + 2048 + o1_)
#define V8B(LO_, HI_) (pg8::v8i){(int)LO_[0], (int)LO_[1], (int)LO_[2], (int)LO_[3], (int)HI_[0], (int)HI_[1], (int)HI_[2], (int)HI_[3]}
__device__ __forceinline__ void qktb8(f32x16& p0, f32x16& p1, const LAS char* Ks, const QB8& q, int r32, int hi) {
  KB8_READ(a0, a1, b0, b1);
  asm volatile("s_waitcnt lgkmcnt(0)" ::: "memory"); SBAR();
  { const pg8::v8i k0 = V8B(a0, a1); asm volatile("s_nop 1\n\tv_mfma_f32_32x32x64_f8f6f4 %0, %1, %2, 0" : "=&v"(p0) : "v"(k0), "v"(q.f)); }
  { const pg8::v8i k1 = V8B(b0, b1); asm volatile("s_nop 1\n\tv_mfma_f32_32x32x64_f8f6f4 %0, %1, %2, 0" : "=&v"(p1) : "v"(k1), "v"(q.f)); }
  asm volatile("s_nop 7\n\ts_nop 7\n\ts_nop 7" ::: "memory");
}
__device__ __forceinline__ void qktb8_fsm(f32x16& n0, f32x16& n1, const LAS char* Ks, const QB8& q, int r32, int hi, f32x16& p0, f32x16& p1, pg8::v8i& pa) {
  KB8_READ(a0, a1, b0, b1);
  asm volatile("" ::: "memory"); SBAR();
#pragma unroll
  for (int r = 0; r < 8; ++r) p1[r] = __builtin_amdgcn_exp2f(p1[r]);
  PIN(p1); SBAR();
  { const pg8::v8i k0 = V8B(a0, a1); asm volatile("s_nop 1\n\tv_mfma_f32_32x32x64_f8f6f4 %0, %1, %2, 0" : "=&v"(n0) : "v"(k0), "v"(q.f)); } SBAR();
#pragma unroll
  for (int r = 8; r < 16; ++r) p1[r] = __builtin_amdgcn_exp2f(p1[r]);
  pa[0] = (int)pg8::pk4_fp8_u(p0[0], p0[1], p0[2], p0[3]);   pa[1] = (int)pg8::pk4_fp8_u(p0[4], p0[5], p0[6], p0[7]);
  PIN(p1); PIN(pa); SBAR();
  { const pg8::v8i k1 = V8B(b0, b1); asm volatile("s_nop 1\n\tv_mfma_f32_32x32x64_f8f6f4 %0, %1, %2, 0" : "=&v"(n1) : "v"(k1), "v"(q.f)); } SBAR();
  pa[2] = (int)pg8::pk4_fp8_u(p0[8], p0[9], p0[10], p0[11]); pa[3] = (int)pg8::pk4_fp8_u(p0[12], p0[13], p0[14], p0[15]);
  pa[4] = (int)pg8::pk4_fp8_u(p1[0], p1[1], p1[2], p1[3]);   pa[5] = (int)pg8::pk4_fp8_u(p1[4], p1[5], p1[6], p1[7]);
  pa[6] = (int)pg8::pk4_fp8_u(p1[8], p1[9], p1[10], p1[11]); pa[7] = (int)pg8::pk4_fp8_u(p1[12], p1[13], p1[14], p1[15]);
  PIN(pa);
  asm volatile("s_nop 7\n\ts_nop 7" ::: "memory");
}
#undef KB8_READ
#undef V8B
__device__ __forceinline__ void add_bias(f32x16& p0, f32x16& p1, const LAS float* bt, int base  ) {
  const LAS float* b = bt + base;
#pragma unroll
  for (int r = 0; r < 16; ++r) { const int c = (r & 3) + 8 * (r >> 2); p0[r] += b[c]; p1[r] += b[32 + c]; }
}

template <int ND0, bool BIAS, int SDEPTH, class QT>
__device__ __forceinline__ void attn_core(const QT& qr, const void* __restrict__ Kh  , const unsigned char* __restrict__ Vt  , LAS char* lds,
                                          f32x16 (&o)[4], f32x16& l_out  , const int qw0  , const float bneg, const float bpos,
                                          Frame& F, WC_PARAMS) {
  constexpr float scale = (ND0 == 8) ? 0.088388347648318440f : 0.125f;
  const int tid = opaque_tid(), wid = __builtin_amdgcn_readfirstlane(tid >> 6), lane = tid & 63, r32 = lane & 31, hi = lane >> 5;
  LAS char* V_lds = lds + OFF_V; LAS char* K_lds = lds + OFF_K;
  LAS float* ws = (LAS float*)(lds + OFF_WS) + wid * 64; LAS float* al_l = ws + 32;
  const LAS float* bt = (const LAS float*)(lds + OFF_BT);
  constexpr float C = scale * 1.4426950408889634f, thr_raw = THR / scale;
  const int qpos = qw0 + r32;
  LAS char* wbuf = lds + OFF_OST + wid * 8192;
  wc_q = 0; if (wc_cur < 0) wconv_issue(F, WC_ARGS, wbuf, lane);
  float m_reg = -1e30f; f32x16 lacc = f32x16{};
  const v4i_f4 ones = {0x22222222, 0x22222222, 0x22222222, 0x22222222};
#pragma unroll
  for (int d = 0; d < 4; ++d) o[d] = f32x16{};
  const int sr = tid >> 4, sc = (tid & 15) * 8;
  const int kr64 = tid >> 3, kc64 = (tid & 7) * 8;
  const int vst = (tid >> 2) * 64 + (((tid & 3) ^ ((tid >> 4) & 3)) << 4), kst8 = (tid >> 3) * 128 + (((tid & 7) ^ ((tid >> 4) & 7)) << 4);
  const int kst4 = (tid >> 2) * 64 + (((tid & 3) ^ ((tid >> 4) & 3)) << 4);
  const int vsw = (r32 >> 2) & 3, voff0 = r32 * 64 + (((2 * hi) ^ vsw) << 4), voff1 = r32 * 64 + (((2 * hi + 1) ^ vsw) << 4);
  struct { u32x4 vs0; bf16x8 ks0; } sr_[SDEPTH];
  const unsigned goff = (unsigned)((sr * LDR + sc) * 2), goff64 = (unsigned)((kr64 * LDR + kc64) * 2), gvoff = (unsigned)tid * 16u;
#define SLOAD(i, k0) do { const char* vt = (const char*)Vt + (size_t)((k0) / KVBLK) * 8192; const char* kt = (const char*)Kh + (size_t)(k0) * (LDR * 2); \
    sr_[i].vs0 = *(const u32x4*)(vt + gvoff); \
    if (ND0 == 8) { sr_[i].ks0 = *(const bf16x8*)((const char*)Kh + (size_t)((k0) / KVBLK) * 8192 + gvoff); } \
    else { if (wid < 4) sr_[i].ks0 = *(const bf16x8*)((const char*)Kh + (size_t)((k0) / KVBLK) * 4096 + gvoff); } } while (0)
#define SWRITE(b, i) do { *(LAS u32x4*)(V_lds + (b) * SHM_V + vst) = sr_[i].vs0; \
    if (ND0 == 8) { *(LAS bf16x8*)(K_lds + (b) * SHM_K + kst8) = sr_[i].ks0; } \
    else { *(LAS bf16x8*)(K_lds + (b) * SHM_K + KSWZ64(kr64, kc64 * 2)) = sr_[i].ks0; } } while (0)
#define SWAIT() do { if (SDEPTH == 1) asm volatile("s_waitcnt vmcnt(0)" ::: "memory"); else asm volatile("s_waitcnt vmcnt(2)" ::: "memory"); } while (0)
#define QKT(P0, P1, KS) do { if constexpr (ND0 == 8) qkt8(P0, P1, KS, qr, r32, hi); else qktb8(P0, P1, KS, qr, r32, hi); } while (0)
#define RESC(a) do { if (__any((a) < 1.f)) { if (hi == 0) al_l[r32] = (a); asm volatile("s_waitcnt lgkmcnt(0)" ::: "memory"); \
    _Pragma("unroll") for (int d = 0; d < 4; ++d) _Pragma("unroll") for (int r = 0; r < 16; ++r) o[d][r] *= al_l[crow(r, hi)]; } } while (0)
#define TBIAS(P0, P1, k0, BR) do { BR = 0.f; if (BIAS) { const int klo = (k0) - qw0; \
    if (klo - 31 >= 91) BR = bpos; else if (klo + 63 <= -91) BR = bneg; else add_bias(P0, P1, bt, (k0) - qpos + 256 + 4 * hi); } } while (0)
  f32x16 pA0, pA1, pB0, pB1; float mnA, mnB, alA, alB, br; pg8::v8i pa; constexpr int NT = SEQ / KVBLK;
#define SWRITE3(sl, i) do { *(LAS u32x4*)(V_lds + (sl) * 8192 + vst) = sr_[i].vs0; \
    if (ND0 == 8) { *(LAS bf16x8*)(K_lds + (sl) * 8192 + kst8) = sr_[i].ks0; } \
    else { if (wid < 4) *(LAS bf16x8*)(K_lds + (sl) * 8192 + kst4) = sr_[i].ks0; } } while (0)
#define NEXT3(x) ((x) == 2 ? 0 : (x) + 1)
#define RESC3(a) do { if (__any((a) < 1.f)) { if (hi == 0) al_l[r32] = (a); asm volatile("s_nop 7\n\ts_nop 7\n\ts_nop 7\n\ts_waitcnt lgkmcnt(0)" ::: "memory"); \
    _Pragma("unroll") for (int r = 0; r < 16; ++r) { const float a_ = al_l[crow(r, hi)]; lacc[r] *= a_; _Pragma("unroll") for (int d = 0; d < 4; ++d) o[d][r] *= a_; } } } while (0)
#define QKT_FSM(N0, N1, KS, P0, P1, AL, VS) do { if constexpr (ND0 == 8) qkt8_fsm(N0, N1, KS, qr, r32, hi, P0, P1, pa, vfr, VS, voff0, voff1); else qktb8_fsm(N0, N1, KS, qr, r32, hi, P0, P1, pa); } while (0)
  VF vfr; constexpr bool PRE = false;
  SLOAD(0, 0); SLOAD(1, KVBLK); asm volatile("s_waitcnt vmcnt(0)" ::: "memory");
  __syncthreads();
  SWRITE3(0, 0); SWRITE3(1, 1); SLOAD(0, 2 * KVBLK);
  wconv_step(F, WC_ARGS, wbuf, lane, false); __syncthreads();
  QKT(pA0, pA1, K_lds); TBIAS(pA0, pA1, 0, br); partialSM(pA0, pA1, m_reg, mnA, alA, C, thr_raw, br);
  int ks = 1, vs = 0, wsl = 2;
#define STAGE3(jj) do { if ((jj) + 2 < NT) { asm volatile("s_waitcnt vmcnt(0)" ::: "memory"); SWRITE3(wsl, 0); } if ((jj) + 3 < NT) SLOAD(0, ((jj) + 3) * KVBLK); \
    wconv_step(F, WC_ARGS, wbuf, lane, (jj) + 2 >= NT); } while (0)
#define STEP(jj, N0, N1, mnN, alN, P0, P1, alP) do { \
    SBAR(); if (wid >= 4) { STAGE3(jj); } SBAR(); \
    QKT_FSM(N0, N1, K_lds + ks * 8192, P0, P1, alP, V_lds + vs * 8192); SBAR(); \
    TBIAS(N0, N1, ((jj) + 1) * KVBLK, br); pv_psm<PRE>(o, V_lds + vs * 8192, voff0, voff1, pa, vfr, N0, N1, m_reg, mnN, alN, C, thr_raw, br, lacc, ones); \
    RESC3(alN); SBAR(); if (wid < 4) { STAGE3(jj); } SBAR(); __syncthreads(); \
    ks = NEXT3(ks); vs = NEXT3(vs); wsl = NEXT3(wsl); } while (0)
  for (int j = 0; j + 2 < NT; j += 2) {
    STEP(j, pB0, pB1, mnB, alB, pA0, pA1, alA);
    STEP(j + 1, pA0, pA1, mnA, alA, pB0, pB1, alB);
  }
  STEP(NT - 2, pB0, pB1, mnB, alB, pA0, pA1, alA);
  finishSM(pB0, pB1, pa); SBAR();
  pv_d0(o, V_lds + vs * 8192, voff0, voff1, pa, lacc, ones);
  asm volatile("s_nop 7\n\ts_nop 7\n\ts_nop 7" ::: "memory");
  l_out = lacc;
#undef SLOAD
#undef SWRITE
#undef SWAIT
#undef QKT
#undef RESC
#undef TBIAS
#undef QKT_FSM
#undef SWRITE3
#undef NEXT3
#undef RESC3
#undef STEP
#undef STAGE3
}
__device__ __forceinline__ void row_rcp(float l_reg, LAS char* lds, float (&rli)[16]) {
  const int tid = opaque_tid(), wid = __builtin_amdgcn_readfirstlane(tid >> 6), lane = tid & 63, r32 = lane & 31, hi = lane >> 5;
  LAS float* li_l = (LAS float*)(lds + OFF_WS) + wid * 64;
  if (hi == 0) li_l[r32] = l_reg; asm volatile("s_waitcnt lgkmcnt(0)" ::: "memory");
#pragma unroll
  for (int r = 0; r < 16; ++r) rli[r] = __builtin_amdgcn_rcpf(li_l[crow(r, hi)]);
  asm volatile("s_waitcnt lgkmcnt(0)" ::: "memory");
}
constexpr float AO_SCALE = 16.f;
__device__ __forceinline__ void stage_store(const f32x16 (&o)[4], LAS char* lds, unsigned char* Ow  ) {
  const int tid = opaque_tid(), wid = __builtin_amdgcn_readfirstlane(tid >> 6), lane = tid & 63, r32 = lane & 31, hi = lane >> 5;
  LAS char* ost = lds + OFF_OST + wid * 8192;
  LAS unsigned char* wb = (LAS unsigned char*)(ost + hi * 512 + r32);
#pragma unroll
  for (int r = 0; r < 16; ++r)
#pragma unroll
    for (int d0 = 0; d0 < 4; ++d0) wb[((r & 3) + 8 * (r >> 2)) * 128 + d0 * 32] = (unsigned char)(__builtin_amdgcn_cvt_pk_fp8_f32(o[d0][r] * AO_SCALE, 0.f, 0, false) & 0xffu);
  asm volatile("s_waitcnt lgkmcnt(0)" ::: "memory");
#pragma unroll 1
  for (int i = 0; i < 4; ++i) { const int row = (lane >> 3) + 8 * i; const u32x4 v = *(const LAS u32x4*)(ost + row * 128 + (lane & 7) * 16);
    *(u32x4*)(Ow + (size_t)row * DM + (lane & 7) * 16) = v; }
  asm volatile("s_waitcnt lgkmcnt(0)" ::: "memory");
}
}

__device__ __forceinline__ void transpose_item(const float* W, int K, int N, bf16* WT, int k0, int n0, int orow0, LAS float* scr, int lane) {
#pragma unroll 8
    for (int i = 0; i < 32; ++i) { const int kk = 2 * i + (lane >> 5); scr[kk * 33 + (lane & 31)] = W[(size_t)(k0 + kk) * N + n0 + (lane & 31)]; }
    LDS_WAIT(); asm volatile("" ::: "memory");
    const int c = lane & 7;
#pragma unroll
    for (int j = 0; j < 4; ++j) { const int n = (lane >> 3) + 8 * j; const LAS float* s = scr + (8 * c) * 33 + n;
        u32x4 o; o.x = pk2(s[0 * 33], s[1 * 33]); o.y = pk2(s[2 * 33], s[3 * 33]); o.z = pk2(s[4 * 33], s[5 * 33]); o.w = pk2(s[6 * 33], s[7 * 33]);
        *(GAS u32x4*)(WT + (size_t)(orow0 + n) * K + k0 + 8 * c) = o; }
    LDS_WAIT(); asm volatile("" ::: "memory");
}
__device__ __forceinline__ void transpose_item_f8(const float* W, int K, int N, unsigned char* WT, int k0, int n0, int orow0, LAS float* scr, int lane) {
#pragma unroll 8
    for (int i = 0; i < 32; ++i) { const int kk = 2 * i + (lane >> 5); scr[kk * 33 + (lane & 31)] = W[(size_t)(k0 + kk) * N + n0 + (lane & 31)]; }
    LDS_WAIT(); asm volatile("" ::: "memory");
    const int c = lane & 7; constexpr float q = pg8::WQ_SCALE;
#pragma unroll
    for (int j = 0; j < 4; ++j) { const int n = (lane >> 3) + 8 * j; const LAS float* s = scr + (8 * c) * 33 + n;
        u32x2 o; o.x = pg8::pk4_fp8(s[0 * 33] * q, s[1 * 33] * q, s[2 * 33] * q, s[3 * 33] * q); o.y = pg8::pk4_fp8(s[4 * 33] * q, s[5 * 33] * q, s[6 * 33] * q, s[7 * 33] * q);
        *(GAS u32x2*)(WT + (size_t)(orow0 + n) * K + k0 + 8 * c) = o; }
    LDS_WAIT(); asm volatile("" ::: "memory");
}
__device__ __forceinline__ int t5_bucket(int rp) {
    const int n = rp < 0 ? -rp : rp; int b;
    if (n < 8) b = n; else { const int j = (31 - __builtin_clz((unsigned)(n * n))) - 6; b = 8 + j; if (b > 15) b = 15; }
    return b + (rp > 0 ? 16 : 0);
}
__device__ __forceinline__ void p0_mod_tables(Frame& F) {
    LAS float* sc = (LAS float*)F.lds;
    LAS float* red = (LAS float*)(F.lds + 32768);
    const int tid = F.tid;
    float* mod = (float*)(F.ws + WS_MOD);
    bool did = false;
    for (int unit = F.vcu; unit < 192; unit += F.G) {
        if (!did) { for (int i = tid; i < NB * DM; i += NTHR) { const float v = F.c[i]; sc[i] = v / (1.f + expf(-v)); } __syncthreads(); did = true; }
        const int n0 = unit * 64, l16 = tid & 15, kr = tid >> 4;
        f32x4 acc[4];
#pragma unroll
        for (int b = 0; b < 4; ++b) acc[b] = (f32x4){0.f, 0.f, 0.f, 0.f};
#pragma unroll 16
        for (int j = 0; j < 64; ++j) { const int k = kr + 32 * j; const f32x4 w = *(const f32x4*)(F.w_ada + (size_t)k * (6 * DM) + n0 + l16 * 4);
#pragma unroll
            for (int b = 0; b < 4; ++b) acc[b] += w * sc[b * DM + k]; }
#pragma unroll
        for (int b = 0; b < 4; ++b) *(LAS f32x4*)(red + (kr * 4 + b) * 64 + l16 * 4) = acc[b];
        __syncthreads();
        if (tid < 256) { const int b = tid >> 6, col = tid & 63; float s = 0.f;
#pragma unroll 8
            for (int q = 0; q < 32; ++q) s += red[(q * 4 + b) * 64 + col];
            mod[b * 6 * DM + n0 + col] = s + F.b_ada[n0 + col]; }
        __syncthreads();
    }
    if (F.vcu == (192 % F.G)) {
        float* rope = (float*)(F.ws + WS_ROPE);
        for (int i = tid; i < 2048; i += NTHR) { const int pos = i >> 5, f = i & 31; const double inv = pow(10000.0, -(double)(2 * f) / 64.0), ang = (double)pos * inv;
            rope[i] = (float)cos(ang); rope[2048 + i] = (float)sin(ang); }
    }
    if (F.vcu == (193 % F.G)) {
        float* bt = (float*)(F.ws + WS_BIAS);
        for (int i = tid; i < 8 * 512; i += NTHR) { const int h = i >> 9, rel = (i & 511) - 256; bt[i] = F.relb[t5_bucket(rel) * 8 + h] * 8.f; }
    }
    if (F.vcu == (194 % F.G) && tid == 0) {
        float s1 = 0.f, s2 = 0.f; for (int i = 0; i < 64; ++i) { s1 += F.lq1[i] * F.lk1[i]; s2 += F.lq2[i] * F.lk2[i]; }
        ((float*)(F.ws + WS_MISC))[0] = expf(s1) - expf(s2) + 0.2f;
    }
}
__device__ __forceinline__ void witem_load(const WItem& d, f32x4 (&v)[8], int lane) {
    const float* p = d.src + (size_t)(lane >> 3) * d.N + (lane & 7) * 4;
#pragma unroll
    for (int i = 0; i < 8; ++i) v[i] = __builtin_nontemporal_load((const f32x4*)(p + (size_t)(8 * i) * d.N));
}
__device__ __forceinline__ void witem_finish(const WItem& d, const f32x4 (&v)[8], LAS float* scr, int lane) {
#pragma unroll
    for (int i = 0; i < 8; ++i) { LAS float* q = scr + (8 * i + (lane >> 3)) * 33 + (lane & 7) * 4; q[0] = v[i].x; q[1] = v[i].y; q[2] = v[i].z; q[3] = v[i].w; }
    LDS_WAIT(); asm volatile("" ::: "memory");
    const int c = lane & 7;
    if (d.f8) { constexpr float q = pg8::WQ_SCALE;
#pragma unroll
        for (int j = 0; j < 4; ++j) { const int n = (lane >> 3) + 8 * j; const LAS float* s = scr + (8 * c) * 33 + n;
            u32x2 o; o.x = pg8::pk4_fp8(s[0 * 33] * q, s[1 * 33] * q, s[2 * 33] * q, s[3 * 33] * q); o.y = pg8::pk4_fp8(s[4 * 33] * q, s[5 * 33] * q, s[6 * 33] * q, s[7 * 33] * q);
            *(GAS u32x2*)(d.dst + (size_t)n * d.pitch + 8 * c) = o; }
    } else {
#pragma unroll
        for (int j = 0; j < 4; ++j) { const int n = (lane >> 3) + 8 * j; const LAS float* s = scr + (8 * c) * 33 + n;
            u32x4 o; o.x = pk2(s[0 * 33], s[1 * 33]); o.y = pk2(s[2 * 33], s[3 * 33]); o.z = pk2(s[4 * 33], s[5 * 33]); o.w = pk2(s[6 * 33], s[7 * 33]);
            *(GAS u32x4*)(d.dst + (size_t)n * d.pitch + 16 * c) = o; }
    }
    LDS_WAIT(); asm volatile("" ::: "memory");
}
__device__ __forceinline__ void p0_weights_strided(Frame& F, int it, int hi) {
    LAS float* scr = (LAS float*)(F.lds + 65536 + F.wave * 8704);
    const int NGW = F.G * NWAVES, lane = opaque_tid() & 63;
    if (it >= hi) return;
    WItem da, db; f32x4 va[8], vb[8];
    witem_decode(F, it, da); witem_load(da, va, lane);
    for (;;) {
        const int itn = it + NGW; const bool hasn = itn < hi;
        if (hasn) { witem_decode(F, itn, db); witem_load(db, vb, lane); }
        witem_finish(da, va, scr, lane);
        if (!hasn) break;
        it = itn + NGW; const bool has2 = it < hi;
        if (has2) { witem_decode(F, it, da); witem_load(da, va, lane); }
        witem_finish(db, vb, scr, lane);
        if (!has2) break;
    }
}

__device__ __forceinline__ void p0_weights(Frame& F, int lo, int hi) { p0_weights_strided(F, lo + F.vcu * NWAVES + F.wave, hi); }
__device__ __forceinline__ void p1_h1(Frame& F) {
    const int gw = F.vcu * NWAVES + F.wave, NGW = F.G * NWAVES, lane = F.lane;
    const float* mod = (const float*)(F.ws + WS_MOD); unsigned char* H = F.ws + WS_H;
    {
        unsigned short* wrp = (unsigned short*)(F.ws + WS_WRP); float* rcst = (float*)(F.ws + WS_RCST);
        for (int i = (int)blockIdx.x * NTHR + F.tid; i < NB * NE * (DM / 8); i += F.G * NTHR) { const int b = i / (NE * (DM / 8)), r = i % (NE * (DM / 8)), e = r / (DM / 8), k0 = (r % (DM / 8)) * 8;
            unsigned hi4[4], lo4[4];
#pragma unroll
            for (int q = 0; q < 4; ++q) { float v[2], h[2];
#pragma unroll
                for (int t = 0; t < 2; ++t) { const int k = k0 + 2 * q + t; v[t] = F.norm_ffn[k] * (mod[b * 6 * DM + 4 * DM + k] + 1.f) * F.w_router[(size_t)k * NE + e]; }
                hi4[q] = cvtpk(v[0], v[1]); h[0] = bflo(hi4[q]); h[1] = bfhi(hi4[q]); lo4[q] = cvtpk(v[0] - h[0], v[1] - h[1]); }
            const size_t o = ((size_t)(b * NE + e) * DM + k0);
            *(u32x4*)(wrp + o) = (u32x4){hi4[0], hi4[1], hi4[2], hi4[3]}; *(u32x4*)(wrp + (size_t)NB * NE * DM + o) = (u32x4){lo4[0], lo4[1], lo4[2], lo4[3]}; }
        if ((int)blockIdx.x < NB * NE) { const int b = (int)blockIdx.x >> 5, e = (int)blockIdx.x & 31;
            LAS float* part = (LAS float*)F.lds; float a = 0.f;
#pragma unroll
            for (int q = 0; q < 4; ++q) { const int k = q * NTHR + F.tid; a += mod[b * 6 * DM + 3 * DM + k] * F.w_router[(size_t)k * NE + e]; }
            a = wave_sum(a); if (F.lane == 0) part[F.wave] = a; __syncthreads();
            if (F.tid == 0) { float t = F.b_router[e];
#pragma unroll
                for (int q = 0; q < NWAVES; ++q) t += part[q];
                rcst[b * 32 + e] = t; }
            __syncthreads(); }
    }
    for (int blk = gw; blk < T / 8; blk += NGW) {
        const int row0 = blk * 8, b = row0 / SEQ;
        f32x4 gm[8], sh[8];
#pragma unroll
        for (int j = 0; j < 8; ++j) { const int col = (lane + 64 * j) * 4; const f32x4 nw = *(const f32x4*)(F.norm_attn + col), scv = *(const f32x4*)(mod + b * 6 * DM + DM + col);
            gm[j] = nw * (scv + 1.f); sh[j] = *(const f32x4*)(mod + b * 6 * DM + col); }
        for (int rr = 0; rr < 8; ++rr) { const int row = row0 + rr;
            const GAS f32x4* xr = (const GAS f32x4*)(F.x + (size_t)row * DM) + lane;
            f32x4 v[8]; float s = 0.f;
#pragma unroll
            for (int j = 0; j < 8; ++j) { v[j] = xr[64 * j]; s += (v[j].x * v[j].x + v[j].y * v[j].y) + (v[j].z * v[j].z + v[j].w * v[j].w); }
            const float rstd = 1.f / sqrtf(wave_sum(s) * (1.f / DM) + EPS);
            GAS unsigned* o4 = (GAS unsigned*)(H + (size_t)row * DM) + lane;
#pragma unroll
            for (int j = 0; j < 8; ++j) { const f32x4 y = v[j] * rstd * gm[j] + sh[j]; o4[64 * j] = pg8::pk4_fp8(y.x, y.y, y.z, y.w); }
        }
    }
}

__device__ __forceinline__ void p2b_knorm(Frame& F) {
    const int gw = F.vcu * NWAVES + F.wave, NGW = F.G * NWAVES, lane = F.lane;
    bf16* P = (bf16*)(F.ws + WS_PROJ); const float* rope = (const float*)(F.ws + WS_ROPE);
    const int ea = (lane & 31) * 4, pa = ea >> 1;
    const f32x4 gka = *(const f32x4*)(F.a_k_norm + ea);
    const int eb = (lane & 3) * 16;
    f32x4 gkb[4];
#pragma unroll
    for (int q = 0; q < 4; ++q) gkb[q] = *(const f32x4*)(F.b_k_norm + eb + 4 * q);
    for (int row = gw; row < T; row += NGW) {
        const int s = row % SEQ, srow = s >> 6, scol = s & 63;
        bf16* pr = P + (size_t)row * INW;
        { GAS u32x2* p = (GAS u32x2*)(pr + COL_KA) + lane; const u32x2 w = *p;
          float v0 = bflo(w.x), v1 = bfhi(w.x), v2 = bflo(w.y), v3 = bfhi(w.y);
          float ss = v0 * v0 + v1 * v1 + v2 * v2 + v3 * v3;
#pragma unroll
          for (int o = 1; o < 32; o <<= 1) ss += __shfl_xor(ss, o);
          const float rstd = 1.f / sqrtf(ss * (1.f / 128.f) + EPS);
          v0 *= rstd * gka.x; v1 *= rstd * gka.y; v2 *= rstd * gka.z; v3 *= rstd * gka.w;
          const int ti = (pa < 32) ? (srow * 32 + pa) : (scol * 32 + pa - 32);
          const float c0 = rope[ti], s0 = rope[2048 + ti], c1 = rope[ti + 1], s1 = rope[2048 + ti + 1];
          *(GAS unsigned*)(F.ws + WS_KA8 + (size_t)(((row / SEQ) * 2 + (lane >> 5)) * 64 + (s >> 6)) * 8192 + (s & 63) * 128 + (lane & 31) * 4) =
              pg8::pk4_fp8(v0 * c0 - v1 * s0, v0 * s0 + v1 * c0, v2 * c1 - v3 * s1, v2 * s1 + v3 * c1); }
        { GAS u32x4* p = (GAS u32x4*)(pr + COL_KB) + lane * 2; const u32x4 w0 = p[0], w1 = p[1];
          float v[16]; v[0] = bflo(w0.x); v[1] = bfhi(w0.x); v[2] = bflo(w0.y); v[3] = bfhi(w0.y); v[4] = bflo(w0.z); v[5] = bfhi(w0.z); v[6] = bflo(w0.w); v[7] = bfhi(w0.w);
          v[8] = bflo(w1.x); v[9] = bfhi(w1.x); v[10] = bflo(w1.y); v[11] = bfhi(w1.y); v[12] = bflo(w1.z); v[13] = bfhi(w1.z); v[14] = bflo(w1.w); v[15] = bfhi(w1.w);
          float ss = 0.f;
#pragma unroll
          for (int q = 0; q < 16; ++q) ss += v[q] * v[q];
          ss += __shfl_xor(ss, 1); ss += __shfl_xor(ss, 2);
          const float rstd = 1.f / sqrtf(ss * (1.f / 64.f) + EPS);
#pragma unroll
          for (int q = 0; q < 16; ++q) v[q] *= rstd * gkb[q >> 2][q & 3];
          u32x4 o8; o8.x = pg8::pk4_fp8(v[0], v[1], v[2], v[3]); o8.y = pg8::pk4_fp8(v[4], v[5], v[6], v[7]); o8.z = pg8::pk4_fp8(v[8], v[9], v[10], v[11]); o8.w = pg8::pk4_fp8(v[12], v[13], v[14], v[15]);
          *(GAS u32x4*)(F.ws + WS_KB8 + (size_t)((((row / SEQ) * 16 + (lane >> 2)) * 64 + (s >> 6))) * 4096 + (s & 63) * 64 + (lane & 3) * 16) = o8; }
    }
    for (int item = gw; item < NB * 10 * 64; item += NGW) {
        const int tile = item & 63, bh = item >> 6, hd = bh % 10, b = bh / 10;
        const int col0 = (hd < 2) ? (COL_VA + hd * 128) : (COL_VB + (hd - 2) * 128);
        const bf16* src = P + (size_t)(b * SEQ + tile * 64) * INW + col0 + 2 * lane;
        unsigned w0[16], w1[16];
#pragma unroll
        for (int g = 0; g < 4; ++g) { unsigned v[16];
#pragma unroll
            for (int t = 0; t < 16; ++t) v[t] = *(const unsigned*)(src + (size_t)(16 * g + t) * INW);
            w0[2 * g]     = pg8::pk4_fp8(bflo(v[0]), bflo(v[1]), bflo(v[2]), bflo(v[3]));     w0[2 * g + 1]     = pg8::pk4_fp8(bflo(v[8]), bflo(v[9]), bflo(v[10]), bflo(v[11]));
            w0[8 + 2 * g] = pg8::pk4_fp8(bflo(v[4]), bflo(v[5]), bflo(v[6]), bflo(v[7]));     w0[8 + 2 * g + 1] = pg8::pk4_fp8(bflo(v[12]), bflo(v[13]), bflo(v[14]), bflo(v[15]));
            w1[2 * g]     = pg8::pk4_fp8(bfhi(v[0]), bfhi(v[1]), bfhi(v[2]), bfhi(v[3]));     w1[2 * g + 1]     = pg8::pk4_fp8(bfhi(v[8]), bfhi(v[9]), bfhi(v[10]), bfhi(v[11]));
            w1[8 + 2 * g] = pg8::pk4_fp8(bfhi(v[4]), bfhi(v[5]), bfhi(v[6]), bfhi(v[7]));     w1[8 + 2 * g + 1] = pg8::pk4_fp8(bfhi(v[12]), bfhi(v[13]), bfhi(v[14]), bfhi(v[15])); }
        GAS u32x4* dst = (GAS u32x4*)(F.ws + WS_VT + (size_t)item * 8192 + (size_t)lane * 128);
#pragma unroll
        for (int q = 0; q < 4; ++q) { dst[q] = (u32x4){w0[4 * q], w0[4 * q + 1], w0[4 * q + 2], w0[4 * q + 3]}; dst[4 + q] = (u32x4){w1[4 * q], w1[4 * q + 1], w1[4 * q + 2], w1[4 * q + 3]}; }
    }
}

__device__ __forceinline__ void attn_unit_A(Frame& F, int ua, WC_PARAMS) {
    const int qb = ua & 15, g = (ua >> 4) & 3, kvh = (ua >> 6) & 1, b = ua >> 7, hq = kvh * 4 + g;
    const int tid = opaque_tid(), wid = F.wave, lane = tid & 63, r32 = lane & 31, hi = lane >> 5;
    const bf16* P = opaque_sptr((const bf16*)(F.ws + WS_PROJ)); const float* rope = (const float*)(F.ws + WS_ROPE);
    const int s = qb * 256 + wid * 32 + r32, row = b * SEQ + s, srow = s >> 6, scol = s & 63;
    attn::QF8 qr;
    { const bf16* qp = P + (size_t)row * INW + COL_QA + hq * 128 + hi * 32;
      u32x4 raw[2][4]; float ss = 0.f;
#pragma unroll
      for (int db = 0; db < 2; ++db)
#pragma unroll
        for (int c = 0; c < 4; ++c) { raw[db][c] = *(const u32x4*)(qp + db * 64 + c * 8);
#pragma unroll
          for (int q = 0; q < 4; ++q) { const float a = bflo(raw[db][c][q]), cc = bfhi(raw[db][c][q]); ss += a * a + cc * cc; } }
      { auto rr = __builtin_amdgcn_permlane32_swap(__float_as_uint(ss), __float_as_uint(ss), false, false); ss = __uint_as_float(rr[0]) + __uint_as_float(rr[1]); }
      const float rstd = 1.f / sqrtf(ss * (1.f / 128.f) + EPS);
#pragma unroll
      for (int db = 0; db < 2; ++db)
#pragma unroll
        for (int c = 0; c < 4; ++c) { const int e0 = db * 64 + hi * 32 + c * 8;
          const f32x4 g0 = *(const f32x4*)(F.a_q_norm + e0), g1 = *(const f32x4*)(F.a_q_norm + e0 + 4);
          const int ti = (db == 0 ? srow : scol) * 32 + hi * 16 + c * 4;
          const f32x4 cs = *(const f32x4*)(rope + ti), sn = *(const f32x4*)(rope + 2048 + ti);
          const u32x4 rw = raw[db][c];
          float v[8]; v[0] = bflo(rw.x) * rstd * g0.x; v[1] = bfhi(rw.x) * rstd * g0.y; v[2] = bflo(rw.y) * rstd * g0.z; v[3] = bfhi(rw.y) * rstd * g0.w;
          v[4] = bflo(rw.z) * rstd * g1.x; v[5] = bfhi(rw.z) * rstd * g1.y; v[6] = bflo(rw.w) * rstd * g1.z; v[7] = bfhi(rw.w) * rstd * g1.w;
          qr.f[db][2 * c]     = (int)pg8::pk4_fp8(v[0] * cs.x - v[1] * sn.x, v[0] * sn.x + v[1] * cs.x, v[2] * cs.y - v[3] * sn.y, v[2] * sn.y + v[3] * cs.y);
          qr.f[db][2 * c + 1] = (int)pg8::pk4_fp8(v[4] * cs.z - v[5] * sn.z, v[4] * sn.z + v[5] * cs.z, v[6] * cs.w - v[7] * sn.w, v[6] * sn.w + v[7] * cs.w); } }
    const unsigned char* Kh = F.ws + WS_KA8 + (size_t)((b * 2 + kvh) * 64) * 8192; const unsigned char* Vh = F.ws + WS_VT + (size_t)((b * 10 + kvh) * 64) * 8192;
    f32x16 o[4]; f32x16 l;
    attn::attn_core<8, false, 2>(qr, Kh, Vh, (LAS char*)F.lds, o, l, qb * 256 + wid * 32, 0.f, 0.f, F, WC_ARGS);
    float rli[16];
#pragma unroll
    for (int r = 0; r < 16; ++r) rli[r] = __builtin_amdgcn_rcpf(l[r]);
#pragma unroll
    for (int d0 = 0; d0 < 4; ++d0)
#pragma unroll
        for (int r = 0; r < 16; ++r) o[d0][r] *= rli[r];
    attn::stage_store(o, (LAS char*)F.lds, F.ws + WS_AO + (size_t)(b * SEQ + qb * 256 + wid * 32) * DM + hq * 128);
}
__device__ __forceinline__ void attn_unit_B(Frame& F, int ub, WC_PARAMS) {
    const int qb = ub & 15, h = (ub >> 4) & 7, b = ub >> 7;
    const int tid = opaque_tid(), wid = F.wave, lane = tid & 63, r32 = lane & 31, hi = lane >> 5;
    const bf16* P = opaque_sptr((const bf16*)(F.ws + WS_PROJ));
    const int s = qb * 256 + wid * 32 + r32, row = b * SEQ + s;
    const float* btg = (const float*)(F.ws + WS_BIAS) + h * 512;
    ((LAS float*)(F.lds + attn::OFF_BT))[tid] = btg[tid];
    const float bneg = __builtin_bit_cast(float, __builtin_amdgcn_readfirstlane(__builtin_bit_cast(int, btg[0])));
    const float bpos = __builtin_bit_cast(float, __builtin_amdgcn_readfirstlane(__builtin_bit_cast(int, btg[511])));
    const float lam = __builtin_bit_cast(float, __builtin_amdgcn_readfirstlane(__builtin_bit_cast(int, ((const float*)(F.ws + WS_MISC))[0])));
    float* stash = (float*)(F.ws + WS_STASH) + (size_t)blockIdx.x * (64 * 512);
    const unsigned char* Vh = F.ws + WS_VT + (size_t)((b * 10 + 2 + h) * 64) * 8192;
    for (int map = 0; map < 2; ++map) {
        attn::QB8 qr;
        { const int tq = opaque_tid(), hi = (tq >> 5) & 1, row = b * SEQ + qb * 256 + wid * 32 + (tq & 31);
          const bf16* qp = P + (size_t)row * INW + COL_QB + h * 128 + map * 64 + hi * 32;
          u32x4 raw[4]; float ss = 0.f;
#pragma unroll
          for (int j = 0; j < 4; ++j) { raw[j] = *(const u32x4*)(qp + j * 8);
#pragma unroll
            for (int q = 0; q < 4; ++q) { const float a = bflo(raw[j][q]), c = bfhi(raw[j][q]); ss += a * a + c * c; } }
          { auto rr = __builtin_amdgcn_permlane32_swap(__float_as_uint(ss), __float_as_uint(ss), false, false); ss = __uint_as_float(rr[0]) + __uint_as_float(rr[1]); }
          const float rstd = 1.f / sqrtf(ss * (1.f / 64.f) + EPS);
#pragma unroll
          for (int j = 0; j < 4; ++j) { const int e0 = hi * 32 + j * 8;
            const f32x4 g0 = *(const f32x4*)(F.b_q_norm + e0), g1 = *(const f32x4*)(F.b_q_norm + e0 + 4);
            qr.f[2 * j]     = (int)pg8::pk4_fp8(bflo(raw[j].x) * rstd * g0.x, bfhi(raw[j].x) * rstd * g0.y, bflo(raw[j].y) * rstd * g0.z, bfhi(raw[j].y) * rstd * g0.w);
            qr.f[2 * j + 1] = (int)pg8::pk4_fp8(bflo(raw[j].z) * rstd * g1.x, bfhi(raw[j].z) * rstd * g1.y, bflo(raw[j].w) * rstd * g1.z, bfhi(raw[j].w) * rstd * g1.w); } }
        const unsigned char* Kh = F.ws + WS_KB8 + (size_t)((b * 16 + h * 2 + map) * 64) * 4096;
        f32x16 o[4]; f32x16 l;
        attn::attn_core<4, true, 2>(qr, Kh, Vh, (LAS char*)F.lds, o, l, qb * 256 + wid * 32, bneg, bpos, F, WC_ARGS);
        float rli[16];
#pragma unroll
        for (int r = 0; r < 16; ++r) rli[r] = __builtin_amdgcn_rcpf(l[r]);
        const int tid = opaque_tid(), r32 = tid & 31;
        if (map == 0) {
#pragma unroll
            for (int d0 = 0; d0 < 4; ++d0)
#pragma unroll
                for (int r = 0; r < 16; r += 4) *(f32x4*)(stash + tid * 64 + d0 * 16 + r) = (f32x4){o[d0][r] * rli[r], o[d0][r + 1] * rli[r + 1], o[d0][r + 2] * rli[r + 2], o[d0][r + 3] * rli[r + 3]};
        } else {
            float ssq[16];
#pragma unroll
            for (int r = 0; r < 16; ++r) ssq[r] = 0.f;
#pragma unroll
            for (int d0 = 0; d0 < 4; ++d0)
#pragma unroll
                for (int r = 0; r < 16; r += 4) { const f32x4 sv = *(const f32x4*)(stash + tid * 64 + d0 * 16 + r);
#pragma unroll
                    for (int q = 0; q < 4; ++q) { const float v = sv[q] - lam * (o[d0][r + q] * rli[r + q]); o[d0][r + q] = v; ssq[r + q] += v * v; } }
#pragma unroll
            for (int r = 0; r < 16; ++r) {
#pragma unroll
                for (int m = 1; m < 32; m <<= 1) ssq[r] += __shfl_xor(ssq[r], m);
                ssq[r] = (1.f / sqrtf(ssq[r] * (1.f / 128.f) + EPS)) * 0.8f; }
            float sg[4];
#pragma unroll
            for (int d0 = 0; d0 < 4; ++d0) sg[d0] = F.b_subln[d0 * 32 + r32];
#pragma unroll
            for (int r = 0; r < 16; ++r)
#pragma unroll
                for (int d0 = 0; d0 < 4; ++d0) o[d0][r] *= ssq[r] * sg[d0];
            attn::stage_store(o, (LAS char*)F.lds, F.ws + WS_AO + (size_t)(b * SEQ + qb * 256 + wid * 32) * DM + 1024 + h * 128);
        }
    }
}
__device__ __forceinline__ void p0_weights_strided(Frame& F, int it, int hi);
__device__ __forceinline__ void p3_attention(Frame& F) {
    int wc_it = P0_ITEMS_A + F.vcu * NWAVES + F.wave, wc_cur = -1, wc_q = 0;
    for (int ub = F.vcu; ub < NB * 8 * 16; ub += F.G) attn_unit_B(F, ub, WC_ARGS);
    for (int ua = F.vcu; ua < NB * 8 * 16; ua += F.G) attn_unit_A(F, ua, WC_ARGS);
    __syncthreads();
    p0_weights_strided(F, wc_it, P0_ITEMS_ALL);
}

__device__ __forceinline__ void p5_router(Frame& F) {
    constexpr int AST = 68;
    LAS float* Abuf = (LAS float*)F.lds;
    LAS float* Wbuf = (LAS float*)(F.lds + 34816);
    LAS float* shb  = (LAS float*)(F.lds + 51200);
    LAS float* red  = (LAS float*)(F.lds + 53248);
    LAS float* lg   = (LAS float*)(F.lds + 118784);
    LAS float* rsd  = (LAS float*)(F.lds + 127232);
    LAS int*   lcnt = (LAS int*)(F.lds + 127488);
    LAS int*   lbase= (LAS int*)(F.lds + 127616);
    LAS float* cstl = (LAS float*)(F.lds + 127744);
    const int tid = F.tid, lane = F.lane, w = F.wave;
    const float* mod = (const float*)(F.ws + WS_MOD);
    int* asg_e = (int*)(F.ws + WS_ASGE); int* asg_p = (int*)(F.ws + WS_ASGP); int* elist = (int*)(F.ws + WS_ELIST); float* egate = (float*)(F.ws + WS_EGATE);
    unsigned char* H = F.ws + WS_H;
    unsigned* gcnt = (unsigned*)(F.ctl + CW_ECNT);
    for (int unit = F.vcu; unit < T / 64; unit += F.G) {
        const int row0 = unit * 64, b = row0 / SEQ;
        const float* shf = mod + b * 6 * DM + 3 * DM; const float* scf = mod + b * 6 * DM + 4 * DM;
        const int srow = tid >> 3;
        float ssq = 0.f;
        const float* xsrc = F.out + (size_t)row0 * DM;
        const unsigned short* wsrc = (const unsigned short*)(F.ws + WS_WRP);
        const unsigned ring0 = (unsigned)__builtin_amdgcn_readfirstlane((int)(unsigned)(unsigned long)F.lds);
        LAS char* abuf = (LAS char*)F.lds + 98304;
        const int xr0 = 8 * w + (lane >> 4), xr1 = xr0 + 4;
        const unsigned xv0 = (unsigned)(xr0 * DM * 4 + (((lane & 15) ^ (xr0 & 15)) << 4)), xv1 = (unsigned)(xr1 * DM * 4 + (((lane & 15) ^ (xr1 & 15)) << 4));
        const int we = 8 * (w & 3) + (lane >> 3);
        const unsigned wv0 = (unsigned)((((size_t)(w >> 2) * NB * NE + (size_t)b * NE + we) * DM) * 2 + ((((lane & 7) ^ ((we >> 1) & 7))) << 4));
#define P5_ISSUE(c_) do { const unsigned st_ = ring0 + (unsigned)(((c_) & 3) * 24576); \
        glds16(xsrc + (c_) * 64, xv0, st_ + (unsigned)((8 * w) * 256)); glds16(xsrc + (c_) * 64, xv1, st_ + (unsigned)((8 * w + 4) * 256)); \
        glds16(wsrc + (c_) * 64, wv0, st_ + 16384u + (unsigned)(w * 1024)); } while (0)
#define P5_SPLIT(c_) do { const LAS char* Xc_ = (const LAS char*)F.lds + ((c_) & 3) * 24576 + srow * 256 + (tid & 7) * 32; \
        f32x4 qa_ = *(const LAS f32x4*)Xc_, qb_ = *(const LAS f32x4*)(Xc_ + 16); \
        ssq += (qa_.x * qa_.x + qa_.y * qa_.y) + (qa_.z * qa_.z + qa_.w * qa_.w) + (qb_.x * qb_.x + qb_.y * qb_.y) + (qb_.z * qb_.z + qb_.w * qb_.w); \
        if (srow & 1) { const f32x4 t_ = qa_; qa_ = qb_; qb_ = t_; }                       \
        u32x4 h_, l_; \
        h_.x = cvtpk(qa_.x, qa_.y); h_.y = cvtpk(qa_.z, qa_.w); h_.z = cvtpk(qb_.x, qb_.y); h_.w = cvtpk(qb_.z, qb_.w); \
        l_.x = cvtpk(qa_.x - bflo(h_.x), qa_.y - bfhi(h_.x)); l_.y = cvtpk(qa_.z - bflo(h_.y), qa_.w - bfhi(h_.y)); \
        l_.z = cvtpk(qb_.x - bflo(h_.z), qb_.y - bfhi(h_.z)); l_.w = cvtpk(qb_.z - bflo(h_.w), qb_.w - bfhi(h_.w)); \
        const int g_ = ((2 * (tid & 7)) ^ (srow & 15)) >> 1;                                \
        LAS char* ad_ = abuf + ((c_) & 1) * 16384 + srow * 128 + ((g_ ^ ((srow >> 1) & 7)) << 4); \
        *(LAS u32x4*)ad_ = h_; *(LAS u32x4*)(ad_ + 8192) = l_; } while (0)
        P5_ISSUE(0); P5_ISSUE(1); P5_ISSUE(2);
        f32x4 accq = (f32x4){0.f, 0.f, 0.f, 0.f};
        const int l16 = lane & 15, lk = lane >> 4, rt = w >> 1, et = w & 1;
        asm volatile("s_waitcnt vmcnt(6)" ::: "memory"); __syncthreads();
        P5_SPLIT(0);
#pragma unroll 1
        for (int c = 0; c < DM / 64; ++c) {
            if (c + 2 < DM / 64) asm volatile("s_waitcnt vmcnt(3)" ::: "memory"); else asm volatile("s_waitcnt vmcnt(0)" ::: "memory");
            __syncthreads();
            if (c + 3 < DM / 64) P5_ISSUE(c + 3);
            if (c + 1 < DM / 64) P5_SPLIT(c + 1);
            const LAS char* Ai = abuf + (c & 1) * 16384 + (rt * 16 + l16) * 128; const int asw = ((rt * 16 + l16) >> 1) & 7;
            const LAS char* Bi = (const LAS char*)F.lds + (c & 3) * 24576 + 16384 + (et * 16 + l16) * 128; const int bsw = ((et * 16 + l16) >> 1) & 7;
#pragma unroll
            for (int s2 = 0; s2 < 2; ++s2) { const int ch = s2 * 4 + lk;
                const bf16x8 ah = *(const LAS bf16x8*)(Ai + ((ch ^ asw) << 4)), al = *(const LAS bf16x8*)(Ai + 8192 + ((ch ^ asw) << 4));
                const bf16x8 bh = *(const LAS bf16x8*)(Bi + ((ch ^ bsw) << 4)), bl = *(const LAS bf16x8*)(Bi + 4096 + ((ch ^ bsw) << 4));
                accq = __builtin_amdgcn_mfma_f32_16x16x32_bf16(al, bh, accq, 0, 0, 0);
                accq = __builtin_amdgcn_mfma_f32_16x16x32_bf16(ah, bl, accq, 0, 0, 0);
                accq = __builtin_amdgcn_mfma_f32_16x16x32_bf16(ah, bh, accq, 0, 0, 0); }
        }
        __syncthreads();
#undef P5_ISSUE
#undef P5_SPLIT
        if (tid < 32) lcnt[tid] = 0;
        if (tid < 32) cstl[tid] = ((const float*)(F.ws + WS_RCST))[b * 32 + tid];
        ssq += __shfl_xor(ssq, 1); ssq += __shfl_xor(ssq, 2); ssq += __shfl_xor(ssq, 4);
        const float rstd = 1.f / sqrtf(ssq * (1.f / DM) + EPS);
        if ((tid & 7) == 0) rsd[srow] = rstd;
        __syncthreads();
#pragma unroll
        for (int r = 0; r < 4; ++r) { const int row = rt * 16 + 4 * lk + r, e = et * 16 + l16; lg[row * 33 + e] = accq[r] * rsd[row] + cstl[e]; }
        __syncthreads();
        int my_e[4], my_lp[4];
        if (tid < 64) { LAS float* lr = lg + tid * 33; float tv[4];
#pragma unroll
            for (int k = 0; k < 4; ++k) { float best = -3.0e38f; int bi = 0;
                for (int e = 0; e < 32; ++e) { const float v = lr[e]; if (v > best) { best = v; bi = e; } }
                tv[k] = best; my_e[k] = bi; lr[bi] = -3.4e38f; }
            const float e1 = expf(tv[1] - tv[0]), e2 = expf(tv[2] - tv[0]), e3 = expf(tv[3] - tv[0]), inv = 1.f / (1.f + e1 + e2 + e3);
            const int t = row0 + tid;
            lr[0] = inv; lr[1] = e1 * inv; lr[2] = e2 * inv; lr[3] = e3 * inv;
#pragma unroll
            for (int k = 0; k < 4; ++k) { asg_e[t * 4 + k] = my_e[k]; my_lp[k] = __hip_atomic_fetch_add(lcnt + my_e[k], 1, __ATOMIC_RELAXED, __HIP_MEMORY_SCOPE_WORKGROUP); } }
        __syncthreads();
        if (tid < 32) lbase[tid] = (int)atomicAdd(gcnt + tid * 16, (unsigned)lcnt[tid]);
        __syncthreads();
        if (tid < 64) { const int t = row0 + tid;
#pragma unroll
            for (int k = 0; k < 4; ++k) { const int pos = lbase[my_e[k]] + my_lp[k]; asg_p[t * 4 + k] = pos; elist[(size_t)my_e[k] * T + pos] = t; egate[(size_t)my_e[k] * T + pos] = lg[tid * 33 + k]; } }
        { f32x4 gm[8], sh[8];
#pragma unroll
          for (int j = 0; j < 8; ++j) { const int col = (lane + 64 * j) * 4; gm[j] = *(const f32x4*)(F.norm_ffn + col) * (*(const f32x4*)(scf + col) + 1.f); sh[j] = *(const f32x4*)(shf + col); }
          f32x4 xr_[2][8];
#pragma unroll
          for (int j = 0; j < 8; ++j) xr_[0][j] = ((const GAS f32x4*)(F.out + (size_t)(row0 + w * 8) * DM) + lane)[64 * j];
#pragma unroll
          for (int rr = 0; rr < 8; ++rr) { const int r = w * 8 + rr; const float rs = rsd[r];
            if (rr + 1 < 8) {
#pragma unroll
              for (int j = 0; j < 8; ++j) xr_[(rr + 1) & 1][j] = ((const GAS f32x4*)(F.out + (size_t)(row0 + r + 1) * DM) + lane)[64 * j]; }
            GAS unsigned* o4 = (GAS unsigned*)(H + (size_t)(row0 + r) * DM) + lane;
#pragma unroll
            for (int j = 0; j < 8; ++j) { const f32x4 y = xr_[rr & 1][j] * rs * gm[j] + sh[j]; o4[64 * j] = pg8::pk4_fp8(y.x, y.y, y.z, y.w); } } }
        __syncthreads();
    }
}

__device__ __forceinline__ void expert_starts(Frame& F, LAS int* pst  ) {
    if (F.tid == 0) { int s = 0; for (int e = 0; e < NE; ++e) { pst[e] = s; const int c = (int)__hip_atomic_load(F.ctl + CW_ECNT + e * 16, RLX_AGENT); s += (c + 255) & ~255; } pst[NE] = s; }
    __syncthreads();
}
template <int NPN, bool GATHER>
__device__ __forceinline__ int grouped_setup(Frame& F, LAS int* ul, LAS int* rt) {
    LAS int* pst = (LAS int*)(F.lds + XTR_OFF + 19456);
    expert_starts(F, pst);
    LAS int* nsh = pst + 34;
    if (F.tid == 0) *nsh = 0;
    __syncthreads();
    if (F.tid < 24) {
        long L = (long)F.tid * F.G + F.vcu; int e = 0, found = 0;
        for (e = 0; e < NE; ++e) { const int nte = (pst[e + 1] - pst[e]) >> 8; const long ne = (long)nte * NPN; if (L < ne) { found = 1; break; } L -= ne; }
        if (found) { const int nte = (pst[e + 1] - pst[e]) >> 8; const int pnl = (int)(L / nte), pml = (int)(L % nte);
            ul[5 * F.tid] = (pst[e] >> 8) + pml; ul[5 * F.tid + 1] = e * NPN + pnl; ul[5 * F.tid + 2] = e; ul[5 * F.tid + 3] = pml * 256;
            ul[5 * F.tid + 4] = (int)__hip_atomic_load(F.ctl + CW_ECNT + e * 16, RLX_AGENT); __hip_atomic_fetch_add(nsh, 1, __ATOMIC_RELAXED, __HIP_MEMORY_SCOPE_WORKGROUP); }
    }
    __syncthreads();
    const int n = *nsh;
    if (GATHER) { const int* elist = (const int*)(F.ws + WS_ELIST);
        for (int q = F.tid; q < n * 256; q += NTHR) { const int u5 = 5 * (q >> 8), lr = ul[u5 + 3] + (q & 255); rt[q] = lr < ul[u5 + 4] ? elist[(size_t)ul[u5 + 2] * T + lr] : 0; } }
    __syncthreads();
    return n;
}

__device__ __forceinline__ void p9_combine(Frame& F) {
    const int gw = F.vcu * NWAVES + F.wave, NGW = F.G * NWAVES, lane = F.lane;
    const float* mod = (const float*)(F.ws + WS_MOD); const unsigned char* Y = F.ws + WS_Y; const int* asg_e = (const int*)(F.ws + WS_ASGE); const int* asg_p = (const int*)(F.ws + WS_ASGP);
    LAS int* pst = (LAS int*)F.lds; expert_starts(F, pst);
    for (int blk = gw; blk < T / 8; blk += NGW) {
        const int row0 = blk * 8, b = row0 / SEQ;
        f32x4 gf[8];
#pragma unroll
        for (int j = 0; j < 8; ++j) gf[j] = *(const f32x4*)(mod + b * 6 * DM + 5 * DM + (lane + 64 * j) * 4) * (1.f / pg8::Y_SCALE);
        for (int rr = 0; rr < 8; ++rr) { const int t = row0 + rr;
            const int r0 = pst[asg_e[t * 4]] + asg_p[t * 4], r1 = pst[asg_e[t * 4 + 1]] + asg_p[t * 4 + 1], r2 = pst[asg_e[t * 4 + 2]] + asg_p[t * 4 + 2], r3 = pst[asg_e[t * 4 + 3]] + asg_p[t * 4 + 3];
            const GAS unsigned* y0 = (const GAS unsigned*)(Y + (size_t)r0 * DM) + lane; const GAS unsigned* y1 = (const GAS unsigned*)(Y + (size_t)r1 * DM) + lane;
            const GAS unsigned* y2 = (const GAS unsigned*)(Y + (size_t)r2 * DM) + lane; const GAS unsigned* y3 = (const GAS unsigned*)(Y + (size_t)r3 * DM) + lane;
            GAS f32x4* xo = (GAS f32x4*)(F.out + (size_t)t * DM) + lane;
#pragma unroll
            for (int j = 0; j < 8; ++j) { const unsigned a = y0[64 * j], bq = y1[64 * j], cq = y2[64 * j], d = y3[64 * j];
                const auto a0 = __builtin_amdgcn_cvt_pk_f32_fp8(a, false), a1 = __builtin_amdgcn_cvt_pk_f32_fp8(a, true), b0 = __builtin_amdgcn_cvt_pk_f32_fp8(bq, false), b1 = __builtin_amdgcn_cvt_pk_f32_fp8(bq, true);
                const auto c0 = __builtin_amdgcn_cvt_pk_f32_fp8(cq, false), c1 = __builtin_amdgcn_cvt_pk_f32_fp8(cq, true), d0 = __builtin_amdgcn_cvt_pk_f32_fp8(d, false), d1 = __builtin_amdgcn_cvt_pk_f32_fp8(d, true);
                f32x4 s; s.x = (a0[0] + b0[0]) + (c0[0] + d0[0]); s.y = (a0[1] + b0[1]) + (c0[1] + d0[1]); s.z = (a1[0] + b1[0]) + (c1[0] + d1[0]); s.w = (a1[1] + b1[1]) + (c1[1] + d1[1]);
                xo[64 * j] = xo[64 * j] + gf[j] * s; } }
    }
}

constexpr int N_PHASES = 11;
struct Args { const float* in[24]; float* out; unsigned char* ws; int ph_lo, ph_hi; };
__global__ void __launch_bounds__(NTHR, 2) fwd_kernel(Args args) {
    extern __shared__ __attribute__((aligned(16))) unsigned char lds[];
    Frame F;
    F.lds = (LAS unsigned char*)lds;
    F.MISC = (volatile LAS unsigned*)(F.lds + MISC_OFF);
    F.tid = threadIdx.x; F.lane = F.tid & 63; F.wave = __builtin_amdgcn_readfirstlane(F.tid >> 6);
    F.G = gridDim.x; { const int bx = blockIdx.x; F.vcu = (F.G % 8 == 0) ? (bx % 8) * (F.G / 8) + bx / 8 : bx; }
    F.ws = args.ws; F.ctl = (gu32*)(args.ws + WS_CTL); F.out = args.out;
    F.x = args.in[0]; F.c = args.in[1]; F.relb = args.in[2]; F.w_ada = args.in[3]; F.b_ada = args.in[4]; F.norm_attn = args.in[5]; F.norm_ffn = args.in[6];
    F.w_in = args.in[7]; F.w_out = args.in[8]; F.a_q_norm = args.in[9]; F.a_k_norm = args.in[10]; F.b_q_norm = args.in[11]; F.b_k_norm = args.in[12];
    F.lq1 = args.in[13]; F.lk1 = args.in[14]; F.lq2 = args.in[15]; F.lk2 = args.in[16]; F.b_subln = args.in[17]; F.w_router = args.in[18]; F.b_router = args.in[19];
    F.w_gu = args.in[20]; F.b_gu = args.in[21]; F.w_down = args.in[22]; F.b_down = args.in[23];
    if (F.tid < 64) ((LAS unsigned*)(F.lds + MISC_OFF))[F.tid] = 0u;
    __syncthreads();
    const int lo = args.ph_lo, hi = args.ph_hi;
    const bool multi = (hi - lo) > 1;
    XcdBarrier bar; bar.bar = (unsigned*)(F.ctl + CW_BAR); bar.x = 0; bar.st = nullptr;
    if (multi) bar = xcd_barrier_post((unsigned*)(F.ctl + CW_BAR), F.MISC + 8);
#ifndef PH_MASK
#define PH_MASK 0x7ff
#endif
#define IN(k) (((PH_MASK >> (k)) & 1) && lo <= (k) && (k) < hi)
#define SEAM(k) do { if (IN(k) && IN((k) + 1)) xcd_barrier(bar); F.tid = opaque_tid(); F.lane = F.tid & 63; } while (0)
#ifndef PROBE_DUP
#define PROBE_DUP 0
#endif
#define REP(k) _Pragma("nounroll") for (int rep_ = 0; rep_ < 1 + ((PROBE_DUP >> (k)) & 1); ++rep_)

    if (IN(0)) REP(0) { p0_mod_tables(F); p0_weights(F, 0, P0_ITEMS_A); }
    SEAM(0);
    if (IN(1)) REP(1) { p1_h1(F); }
    SEAM(1);
    if (IN(2)) REP(2) {
        pg8::Gemm g{F.ws + WS_H, F.ws + WS_WIN, DM}; pg8::StaticOrder S; S.init(T, INW, DM, F.G, (int)blockIdx.x);
        pg8::EpiProj E{(bf16*)(F.ws + WS_PROJ), INW, 1.f / 32.f};
        pg8::gemm_phase<pg8::EpiProj, pg8::StaticOrder, true, true>(F.lds, g, S, E);
    }
    SEAM(2);
    if (IN(3)) p2b_knorm(F);
    SEAM(3);
    if (IN(4)) REP(4) p3_attention(F);
    SEAM(4);
    if (IN(5)) REP(5) {
        pg8::Gemm g{F.ws + WS_AO, F.ws + WS_WOUT, DM}; pg8::StaticOrder S; S.init(T, DM, DM, F.G, (int)blockIdx.x);
        pg8::EpiResid E{F.x, F.out, (const float*)(F.ws + WS_MOD) + 2 * DM, 1.f / (pg8::WQ_SCALE * attn::AO_SCALE)};
        pg8::gemm_phase<pg8::EpiResid, pg8::StaticOrder, true, true>(F.lds, g, S, E);
    }
    SEAM(5);
    if (IN(6)) p5_router(F);
    SEAM(6);
    if (IN(8)) REP(8) {
        LAS int* rt = (LAS int*)(F.lds + XTR_OFF); LAS int* ul = (LAS int*)(F.lds + XTR_OFF + 18432);
        const int n = grouped_setup<16, true>(F, ul, rt);
        pg8::Gemm g{F.ws + WS_H, F.ws + WS_WGU, DM}; pg8::GroupedOrder<true> S{ul, n, rt, DM};
        pg8::EpiSwiglu E{F.ws + WS_ACT, F.b_gu};
        pg8::gemm_phase<pg8::EpiSwiglu, pg8::GroupedOrder<true>, true, true>(F.lds, g, S, E);
    }
    SEAM(8);
    if (IN(9)) REP(9) {
        LAS int* rt = (LAS int*)(F.lds + XTR_OFF); LAS int* ul = (LAS int*)(F.lds + XTR_OFF + 18432);
        const int n = grouped_setup<8, false>(F, ul, rt);
        pg8::Gemm g{F.ws + WS_ACT, F.ws + WS_WDN, FF}; pg8::GroupedOrder<false> S{ul, n, rt, FF};
        pg8::EpiDown E{F.ws + WS_Y, F.b_down, (const float*)(F.ws + WS_EGATE)};
        pg8::gemm_phase<pg8::EpiDown, pg8::GroupedOrder<false>, true, true>(F.lds, g, S, E);
    }
    SEAM(9);
    if (IN(10)) p9_combine(F);
#undef IN
#undef SEAM
}

extern "C" void kernel_launch(void* const* d_in, const int* in_sizes, int n_in, void* d_out, int out_size, void* d_ws, size_t ws_size, hipStream_t stream) {
    static int grid = 0;
    if (grid == 0) {
        if (n_in != 24 || in_sizes[0] != T * DM || out_size != T * DM || ws_size < WS_END) {
            fprintf(stderr, "kernel_launch: shape mismatch: n_in %d in0 %d out %d ws %zu (need %zu)\n", n_in, n_in > 0 ? in_sizes[0] : -1, out_size, ws_size, (size_t)WS_END); grid = -1; return; }
        int dev = 0, cus = 0, per_cu = 0;
        if (hipGetDevice(&dev) != hipSuccess || hipDeviceGetAttribute(&cus, hipDeviceAttributeMultiprocessorCount, dev) != hipSuccess) { fprintf(stderr, "kernel_launch: device query failed\n"); grid = -1; return; }
        if (hipFuncSetAttribute((const void*)fwd_kernel, hipFuncAttributeMaxDynamicSharedMemorySize, LDS_BYTES) != hipSuccess) { fprintf(stderr, "kernel_launch: hipFuncSetAttribute failed\n"); grid = -1; return; }
        if (hipOccupancyMaxActiveBlocksPerMultiprocessor(&per_cu, (const void*)fwd_kernel, NTHR, LDS_BYTES) != hipSuccess || per_cu < 1)
            fprintf(stderr, "kernel_launch: note: occupancy query reports %d workgroups per CU\n", per_cu);
        (void)hipGetLastError();
        grid = cus;
        if (grid != 256) { fprintf(stderr, "kernel_launch: built for a 256-CU device, found %d CUs\n", cus); grid = -1; return; }
    }
    if (grid < 0) return;
    if (hipMemsetAsync((char*)d_ws + WS_CTL, 0, CTL_ZERO, stream) != hipSuccess) { fprintf(stderr, "kernel_launch: memset failed\n"); return; }
    Args a{};
    for (int i = 0; i < 24; ++i) a.in[i] = (const float*)d_in[i];
    a.out = (float*)d_out; a.ws = (unsigned char*)d_ws;
#if MK_ONE_LAUNCH
    a.ph_lo = 0; a.ph_hi = N_PHASES;
    hipLaunchKernelGGL(fwd_kernel, dim3(grid), dim3(NTHR), LDS_BYTES, stream, a);
#else
    for (int p = 0; p < N_PHASES; ++p) { a.ph_lo = p; a.ph_hi = p + 1; hipLaunchKernelGGL(fwd_kernel, dim3(grid), dim3(NTHR), LDS_BYTES, stream, a); }
#endif
    const hipError_t le = hipPeekAtLastError();
    if (le != hipSuccess) fprintf(stderr, "kernel_launch: launch failed: %s\n", hipGetErrorName(le));
}
```
